# Optimizing an MI355X kernel written in HIP

```python
import jax, jax.numpy as jnp
from jax import lax
import numpy as np

D_MODEL = 1024
BATCH = 16
SEQ = 256
DEPTH = 2
DEC_BATCH = 4
DEC_SEQ = 4096
PAST_LEN = 256

GRID_W = 64
N_MIXERS = 2
N_A = (DEPTH + 1) // 2
N_B = DEPTH // 2
HG_HEADS = 8
HG_DK = D_MODEL // HG_HEADS
HG_DV = D_MODEL // HG_HEADS
SCAN_CHUNK = 64
MIX_CHUNK = 128
ROWS_PER_CHUNK = MIX_CHUNK // GRID_W
CM_GROUPS = 8
CM_GROUP_W = D_MODEL // CM_GROUPS
D_FF = 4 * D_MODEL
N_MOD = 6
EPS = 1e-6

kernel_name = "hybrid_hgrn2_chunkmlp_diffusion_step"


def rmsnorm(x, g):
    xf = x.astype(jnp.float32)
    y = xf * lax.rsqrt(jnp.mean(xf * xf, axis=-1, keepdims=True) + EPS)
    return (y * g.astype(jnp.float32)).astype(x.dtype)


def layernorm(x, g, b):
    xf = x.astype(jnp.float32)
    mu = jnp.mean(xf, axis=-1, keepdims=True)
    var = jnp.mean(jnp.square(xf - mu), axis=-1, keepdims=True)
    y = (xf - mu) * lax.rsqrt(var + EPS) * g.astype(jnp.float32) + b.astype(jnp.float32)
    return y.astype(x.dtype)


def adaln(cvec, w, b):
    m = jax.nn.silu(cvec) @ w + b
    return [t[:, None, :] for t in jnp.split(m, N_MOD, axis=-1)]


def gla_scan(q, k, v, g, s0):
    Bn, L, H, _ = q.shape
    DV = v.shape[-1]
    n = L // SCAN_CHUNK

    def to_chunks(a):
        return a.reshape(Bn, n, SCAN_CHUNK, a.shape[2], a.shape[3]).transpose(1, 0, 3, 2, 4)

    mask = jnp.tril(jnp.ones((SCAN_CHUNK, SCAN_CHUNK), dtype=bool))[:, :, None]

    def step(S, inp):
        qc, kc, vc, gc = inp
        b = jnp.cumsum(gc, axis=2)
        o = jnp.einsum('bhtk,bhkv->bhtv', qc * jnp.exp(b), S)
        diff = jnp.where(mask, b[:, :, :, None, :] - b[:, :, None, :, :], -jnp.inf)
        att = jnp.einsum('bhtk,bhsk,bhtsk->bhts', qc, kc, jnp.exp(diff))
        o = o + jnp.einsum('bhts,bhsv->bhtv', att, vc)
        b_last = b[:, :, -1:, :]
        S = jnp.exp(b_last[:, :, 0, :])[..., None] * S + jnp.einsum(
            'bhsk,bhsv->bhkv', kc * jnp.exp(b_last - b), vc)
        return S, o

    S, o = lax.scan(step, s0.astype(jnp.float32), (to_chunks(q), to_chunks(k), to_chunks(v), to_chunks(g)))
    o = o.transpose(1, 0, 3, 2, 4).reshape(Bn, L, H, DV)
    return o, S


def hgrn2_mixer(h, s0_fwd, s0_bwd, w_in, lb, onorm_g, w_out):
    Bn, L, _ = h.shape
    z = h @ w_in
    zq, zff, zfb, zi, zg = jnp.split(z, 5, axis=-1)
    q = jax.nn.silu(zq.astype(jnp.float32)).reshape(Bn, L, HG_HEADS, HG_DK)
    v = zi.astype(jnp.float32).reshape(Bn, L, HG_HEADS, HG_DV)

    def gates(zf, lbd):
        f = lbd + (1.0 - lbd) * jax.nn.sigmoid(zf.astype(jnp.float32))
        return (1.0 - f).reshape(Bn, L, HG_HEADS, HG_DK), jnp.log(f).reshape(Bn, L, HG_HEADS, HG_DK)

    k_f, g_f = gates(zff, lb[0])
    k_b, g_b = gates(zfb, lb[1])
    o_f, s_f = gla_scan(q, k_f, v, g_f, s0_fwd)
    rev = lambda a: jnp.flip(a, axis=1)
    o_b, s_b = gla_scan(rev(q), rev(k_b), rev(v), rev(g_b), s0_bwd)
    o = o_f + rev(o_b)
    o = o * lax.rsqrt(jnp.mean(o * o, axis=-1, keepdims=True) + EPS) * onorm_g.astype(jnp.float32)
    o = o.reshape(Bn, L, D_MODEL) * jax.nn.silu(zg.astype(jnp.float32))
    return o.astype(h.dtype) @ w_out, s_f, s_b


def chunk_mlp_mixer(h, n_chunks, w_in, ln_g, ln_b, w_s, b_s, w_out):
    Bn, L, _ = h.shape
    z = jax.nn.gelu(h @ w_in)
    u, v = jnp.split(z, 2, axis=-1)
    v = layernorm(v, ln_g, ln_b).reshape(Bn, n_chunks, MIX_CHUNK, CM_GROUPS, CM_GROUP_W)
    s = jnp.einsum('gpq,bnqgc->bnpgc', w_s, v) + b_s.T[:, :, None]
    return (u * s.reshape(Bn, L, D_MODEL)) @ w_out


def sqrelu_mlp(h, w1, w2):
    return jnp.square(jax.nn.relu(h @ w1)) @ w2


def setup_inputs(seed: int = 0) -> dict:
    key = jax.random.key(seed)
    ks = jax.random.split(key, 24)
    nrm = lambda k, shape, s=1.0: jax.random.normal(k, shape, jnp.float32) * s
    D = D_MODEL
    return {
        "x_prompt": nrm(ks[0], (BATCH, SEQ, D)),
        "x_sample": nrm(ks[1], (DEC_BATCH, DEC_SEQ, D)),
        "state_hgrn": nrm(ks[2], (DEC_BATCH, N_A, 2, HG_HEADS, HG_DK, HG_DV), 0.5),
        "c": nrm(ks[3], (DEC_BATCH, D)),
        "c_ctx": nrm(ks[4], (D,)),
        "ada_w": nrm(ks[5], (DEPTH, D, N_MOD * D), 0.5 * D ** -0.5),
        "ada_b": nrm(ks[6], (DEPTH, N_MOD * D), 0.02),
        "norm_mix_g": 1.0 + nrm(ks[7], (DEPTH, D), 0.02),
        "norm_mlp_g": 1.0 + nrm(ks[8], (DEPTH, D), 0.02),
        "mlp_w1": nrm(ks[9], (DEPTH, D, D_FF), D ** -0.5),
        "mlp_w2": nrm(ks[10], (DEPTH, D_FF, D), D_FF ** -0.5),
        "hgrn_w_in": nrm(ks[11], (N_A, D, 5 * D), D ** -0.5),
        "hgrn_lb_logits": nrm(ks[12], (N_A + 1, 2, HG_HEADS * HG_DK)),
        "hgrn_onorm_g": 1.0 + nrm(ks[13], (N_A, HG_HEADS, HG_DV), 0.02),
        "hgrn_w_out": nrm(ks[14], (N_A, D, D), D ** -0.5),
        "cm_w_in": nrm(ks[15], (N_B, D, 2 * D), D ** -0.5),
        "cm_ln_g": 1.0 + nrm(ks[16], (N_B, D), 0.02),
        "cm_ln_b": nrm(ks[17], (N_B, D), 0.02),
        "cm_w_s": nrm(ks[18], (N_B, CM_GROUPS, MIX_CHUNK, MIX_CHUNK), MIX_CHUNK ** -0.5),
        "cm_b_s": 1.0 + nrm(ks[19], (N_B, CM_GROUPS, MIX_CHUNK), 0.02),
        "cm_w_out": nrm(ks[20], (N_B, D, D), D ** -0.5),
        "final_norm_g": 1.0 + nrm(ks[21], (D,), 0.02),
    }


def reference(x_prompt, x_sample, state_hgrn, c, c_ctx, ada_w, ada_b, norm_mix_g, norm_mlp_g,
              mlp_w1, mlp_w2, hgrn_w_in, hgrn_lb_logits, hgrn_onorm_g, hgrn_w_out,
              cm_w_in, cm_ln_g, cm_ln_b, cm_w_s, cm_b_s, cm_w_out, final_norm_g):
    ctx = x_prompt
    lat = x_sample
    n_ctx_batch, ctx_len, _ = ctx.shape
    rows = lat.shape[1] // GRID_W
    ctx_cond = c_ctx[None, :]
    lb_all = jnp.cumsum(jax.nn.softmax(hgrn_lb_logits.astype(jnp.float32), axis=0), axis=0)
    zero_state = jnp.zeros((n_ctx_batch, HG_HEADS, HG_DK, HG_DV), jnp.float32)
    new_states = []
    for i in range(DEPTH):
        j = i // N_MIXERS
        sh1c, sc1c, gt1c, sh2c, sc2c, gt2c = adaln(ctx_cond, ada_w[i], ada_b[i])
        sh1l, sc1l, gt1l, sh2l, sc2l, gt2l = adaln(c, ada_w[i], ada_b[i])
        h_ctx = rmsnorm(ctx, norm_mix_g[i]) * (1.0 + sc1c) + sh1c
        h_lat = rmsnorm(lat, norm_mix_g[i]) * (1.0 + sc1l) + sh1l
        if i % N_MIXERS == 0:
            o_ctx, s_f, s_b = hgrn2_mixer(h_ctx, zero_state, zero_state, hgrn_w_in[j], lb_all[j],
                                          hgrn_onorm_g[j], hgrn_w_out[j])
            o_lat, _, _ = hgrn2_mixer(h_lat, state_hgrn[:, j, 0], state_hgrn[:, j, 1], hgrn_w_in[j],
                                      lb_all[j], hgrn_onorm_g[j], hgrn_w_out[j])
            new_states.append(jnp.stack([s_f, s_b], axis=1).astype(x_prompt.dtype))
        else:
            o_ctx = chunk_mlp_mixer(h_ctx, ctx_len // MIX_CHUNK, cm_w_in[j], cm_ln_g[j], cm_ln_b[j],
                                    cm_w_s[j], cm_b_s[j], cm_w_out[j])
            o_lat = chunk_mlp_mixer(h_lat, rows // ROWS_PER_CHUNK, cm_w_in[j], cm_ln_g[j], cm_ln_b[j],
                                    cm_w_s[j], cm_b_s[j], cm_w_out[j])
        ctx = ctx + gt1c * o_ctx
        lat = lat + gt1l * o_lat
        h_ctx = rmsnorm(ctx, norm_mlp_g[i]) * (1.0 + sc2c) + sh2c
        h_lat = rmsnorm(lat, norm_mlp_g[i]) * (1.0 + sc2l) + sh2l
        ctx = ctx + gt2c * sqrelu_mlp(h_ctx, mlp_w1[i], mlp_w2[i])
        lat = lat + gt2l * sqrelu_mlp(h_lat, mlp_w1[i], mlp_w2[i])
    y_prompt = rmsnorm(ctx, final_norm_g)
    y_sample = rmsnorm(lat, final_norm_g)
    new_state_hgrn = jnp.stack(new_states, axis=1)
    return (y_prompt, y_sample, new_state_hgrn)
```

```cpp
#include <hip/hip_runtime.h>
#include <cstdio>
#include <cstdint>

#ifndef MK_LAUNCH_PER_PHASE
#define MK_LAUNCH_PER_PHASE 1
#endif

#define GAS __attribute__((address_space(1)))
#define LAS __attribute__((address_space(3)))
typedef _Float16 h16;
typedef _Float16 h16x2 __attribute__((ext_vector_type(2)));
typedef _Float16 h16x4 __attribute__((ext_vector_type(4)));
typedef _Float16 h16x8 __attribute__((ext_vector_type(8)));
typedef float f32x2 __attribute__((ext_vector_type(2)));
typedef float f32x4 __attribute__((ext_vector_type(4)));
typedef unsigned u32x2 __attribute__((ext_vector_type(2)));
typedef unsigned u32x4 __attribute__((ext_vector_type(4)));
typedef unsigned short bf16_t;
typedef __bf16 bf16x2_t __attribute__((ext_vector_type(2)));

constexpr int D = 1024, M_CTX = 4096, M_LAT = 16384, M = M_CTX + M_LAT, FF = 4096, NCOND = 5, NH = 8, HD = 128;
constexpr int N_HIN = 5 * D, N_CIN = 2 * D;
constexpr float EPS = 1e-6f;
constexpr int NWAVES = 8, NTHREADS = 512, NPHASES = 14;

constexpr size_t MiB = 1u << 20;
constexpr size_t WS_CTL = 0, CTL_ZERO_BYTES = 1 * MiB;
constexpr int CW_TMO = 0, CW_BAR = 1024, CW_MOD = 8192, CW_RSQ_A = CW_MOD + 2 * NCOND * 6 * D, CW_RSQ_B = CW_RSQ_A + M, CW_RSQ_C = CW_RSQ_B + M,
              CW_RSQ_D = CW_RSQ_C + M, CW_VS1 = CW_RSQ_D + M, CW_VS2 = CW_VS1 + M, CW_END = CW_VS2 + M;
static_assert((size_t)CW_END * 4 <= CTL_ZERO_BYTES, "ctl words");
constexpr size_t WS_VEC = 1 * MiB;
constexpr int VW_GN = 0  , VW_BMLP = VW_GN + 3 * NCOND * D  , VW_BCM = VW_BMLP + 2 * NCOND * FF  , VW_LB = VW_BCM + NCOND * N_CIN  , VW_END = VW_LB + 2 * D;
static_assert((size_t)VW_END * 4 <= MiB, "vec words");
constexpr size_t WS_W_HIN = 2 * MiB, WS_W_HOUT = 12 * MiB, WS_W_CIN = 14 * MiB, WS_W_COUT = 18 * MiB, WS_W_W1 = 20 * MiB  , WS_W_W2 = 36 * MiB  , WS_W_WS = 52 * MiB;
constexpr size_t WS_AY = 54 * MiB, WS_AX = 94 * MiB, WS_Q = 134 * MiB, WS_V = 174 * MiB, WS_G = 214 * MiB, WS_END = 254 * MiB;
constexpr size_t WS_HID = WS_AX;
constexpr size_t WS_U = WS_Q, WS_V2 = WS_V;
constexpr size_t ACT_BYTES = (size_t)M * D * 2;
static_assert(ACT_BYTES == 40 * MiB && WS_HID + (size_t)M * FF * 2 == WS_END, "map");

__device__ __forceinline__ float ex2(float x) { return __builtin_amdgcn_exp2f(x); }
__device__ __forceinline__ float rcpf(float x) { return __builtin_amdgcn_rcpf(x); }
__device__ __forceinline__ float sigmoidf_(float x) { return rcpf(1.0f + ex2(-1.4426950408889634f * x)); }
__device__ __forceinline__ float siluf_(float x) { return x * sigmoidf_(x); }
__device__ __forceinline__ float gelu_tanh(float x) { const float y = 0.7978845608028654f * (x + 0.044715f * x * x * x); const float t = 1.0f - 2.0f * rcpf(1.0f + ex2(2.885390081777927f * y)); return 0.5f * x * (1.0f + t); }
__device__ __forceinline__ float bf2f(bf16_t b) { return __uint_as_float((unsigned)b << 16); }
__device__ __forceinline__ unsigned pk_bf16(float lo, float hi) { f32x2 v = {lo, hi}; bf16x2_t b = __builtin_convertvector(v, bf16x2_t); return __builtin_bit_cast(unsigned, b); }
__device__ __forceinline__ unsigned pk_h16(float lo, float hi) { f32x2 v = {lo, hi}; h16x2 b = __builtin_convertvector(v, h16x2); return __builtin_bit_cast(unsigned, b); }
__device__ __forceinline__ void st_h16x4(h16* p, f32x4 v) { u32x2 w; w.x = pk_h16(v.x, v.y); w.y = pk_h16(v.z, v.w); *(u32x2*)p = w; }
__device__ __forceinline__ void st_bf16x4(bf16_t* p, f32x4 v) { u32x2 w; w.x = pk_bf16(v.x, v.y); w.y = pk_bf16(v.z, v.w); *(u32x2*)p = w; }
__device__ __forceinline__ float wave_sum(float v) {
#pragma unroll
    for (int o = 1; o < 64; o <<= 1) v += __shfl_xor(v, o);
    return v;
}
__device__ __forceinline__ int cond_of_row(int row) { return row < M_CTX ? 0 : 1 + ((row - M_CTX) >> 12); }

struct Args { const float* in[22]; float* out; unsigned char* ws; int ph_lo, ph_hi; };

struct Ctx {
    LAS unsigned char* lds;
    int tid, lane, wave, vcu, G;
    const float* const* in; float* out; unsigned char* ws;
    float* ctlf; float* vec;
};

struct EpiWin {
    static constexpr bool STATS = false;
    h16* Q; h16* ZF; h16* ZB; bf16_t* V; h16* Gt;
    __device__ __forceinline__ void apply(int row, int col, f32x4 a, float&, float&) const {
        const int grp = col >> 10, cc = col & 1023; const size_t off = (size_t)row * D + cc;
        if (grp == 0) { f32x4 s = {siluf_(a.x), siluf_(a.y), siluf_(a.z), siluf_(a.w)}; st_h16x4(Q + off, s); }
        else if (grp == 1) st_h16x4(ZF + off, a);
        else if (grp == 2) st_h16x4(ZB + off, a);
        else if (grp == 3) st_bf16x4(V + off, a);
        else { f32x4 s = {siluf_(a.x), siluf_(a.y), siluf_(a.z), siluf_(a.w)}; st_h16x4(Gt + off, s); }
    }
    __device__ __forceinline__ void commit(int, int, float, float) const {}
};
struct EpiRes {
    static constexpr bool STATS = true;
    const float* xp; const float* xs;
    float* out; const float* gate;
    const float* gn; h16* Aout;
    float* rsq;
    __device__ __forceinline__ void apply(int row, int col, f32x4 a, float&, float& s2) const {
        const int cond = cond_of_row(row); const size_t off = (size_t)row * D + col;
        const float* xo = xp ? (row < M_CTX ? xp + off : xs + (off - (size_t)M_CTX * D)) : out + off;
        const f32x4 x0 = *(const f32x4*)xo, g = *(const f32x4*)(gate + cond * 6 * D + col);
        const f32x4 xn = x0 + g * a;
        *(f32x4*)(out + off) = xn;
        s2 += (xn.x * xn.x + xn.y * xn.y) + (xn.z * xn.z + xn.w * xn.w);
        if (Aout) { const f32x4 gv = *(const f32x4*)(gn + cond * D + col); st_h16x4(Aout + off, xn * gv); }
    }
    __device__ __forceinline__ void commit(int row, int, float, float s2) const { atomicAdd(rsq + row, s2); }
};
struct EpiHid {
    static constexpr bool STATS = false;
    const float* rsq; const float* bias; h16* H;
    __device__ __forceinline__ void apply(int row, int col, f32x4 a, float&, float&) const {
        const int cond = cond_of_row(row); const float rstd = rsqrtf(rsq[row] * (1.0f / D) + EPS);
        const f32x4 b = *(const f32x4*)(bias + cond * FF + col);
        f32x4 z = a * rstd + b; z.x = fmaxf(z.x, 0.f); z.y = fmaxf(z.y, 0.f); z.z = fmaxf(z.z, 0.f); z.w = fmaxf(z.w, 0.f);
        st_h16x4(H + (size_t)row * FF + col, z * z);
    }
    __device__ __forceinline__ void commit(int, int, float, float) const {}
};
struct EpiCin {
    static constexpr bool STATS = true;
    const float* rsq; const float* bias; h16* U; h16* V2; float* vs1; float* vs2;
    __device__ __forceinline__ void apply(int row, int col, f32x4 a, float& s1, float& s2) const {
        const int cond = cond_of_row(row); const float rstd = rsqrtf(rsq[row] * (1.0f / D) + EPS);
        const f32x4 b = *(const f32x4*)(bias + cond * N_CIN + col);
        f32x4 z = a * rstd + b; z.x = gelu_tanh(z.x); z.y = gelu_tanh(z.y); z.z = gelu_tanh(z.z); z.w = gelu_tanh(z.w);
        if (col < D) st_h16x4(U + (size_t)row * D + col, z);
        else { st_h16x4(V2 + (size_t)row * D + (col - D), z); s1 += (z.x + z.y) + (z.z + z.w); s2 += (z.x * z.x + z.y * z.y) + (z.z * z.z + z.w * z.w); }
    }
    __device__ __forceinline__ void commit(int row, int col, float s1, float s2) const { if (col >= D) { atomicAdd(vs1 + row, s1); atomicAdd(vs2 + row, s2); } }
};

template <class Epi>
__device__ __forceinline__ void naive_gemm_phase(const Ctx& C, const h16* A, const h16* Wt, int Mr, int N, int K, const Epi& E) {
    LAS float* As = (LAS float*)C.lds; LAS float* Bs = As + 16 * 132;
    const int tid = C.tid, ty = tid >> 5, tx = tid & 31;
    const int ntn = N / 128, ntiles = (Mr / 128) * ntn;
    for (int t = C.vcu; t < ntiles; t += C.G) {
        const int pm = t / ntn, pn = t % ntn;
        f32x4 acc[8];
#pragma unroll
        for (int i = 0; i < 8; ++i) acc[i] = (f32x4){0.f, 0.f, 0.f, 0.f};
        const int r = tid >> 2, kk = (tid & 3) * 4;
        const h16* ap = A + (size_t)(pm * 128 + r) * K + kk; const h16* bp = Wt + (size_t)(pn * 128 + r) * K + kk;
        for (int k0 = 0; k0 < K; k0 += 16) {
            const h16x4 a = *(const h16x4*)(ap + k0), b = *(const h16x4*)(bp + k0);
            __syncthreads();
#pragma unroll
            for (int j = 0; j < 4; ++j) { As[(kk + j) * 132 + r] = (float)a[j]; Bs[(kk + j) * 132 + r] = (float)b[j]; }
            __syncthreads();
#pragma unroll 2
            for (int k = 0; k < 16; ++k) {
                const f32x4 a0 = *(LAS f32x4*)(As + k * 132 + ty * 8), a1 = *(LAS f32x4*)(As + k * 132 + ty * 8 + 4), bv = *(LAS f32x4*)(Bs + k * 132 + tx * 4);
                acc[0] += a0.x * bv; acc[1] += a0.y * bv; acc[2] += a0.z * bv; acc[3] += a0.w * bv;
                acc[4] += a1.x * bv; acc[5] += a1.y * bv; acc[6] += a1.z * bv; acc[7] += a1.w * bv;
            }
        }
#pragma unroll
        for (int i = 0; i < 8; ++i) { float s1 = 0.f, s2 = 0.f; const int row = pm * 128 + ty * 8 + i, col = pn * 128 + tx * 4; E.apply(row, col, acc[i], s1, s2); E.commit(row, col, s1, s2); }
    }
    __syncthreads();
}

__device__ __forceinline__ void p0_transpose_item(const float* W, int K, int N, h16* WT, LAS float* scr, int item, int lane) {
    const int nblk = N / 32, kb = item / nblk, nb = item % nblk, k0 = 64 * kb, n0 = 32 * nb;
#pragma unroll 8
    for (int i = 0; i < 32; ++i) { const int kk = 2 * i + (lane >> 5); scr[kk * 33 + (lane & 31)] = W[(size_t)(k0 + kk) * N + n0 + (lane & 31)]; }
    asm volatile("s_waitcnt lgkmcnt(0)" ::: "memory");
    const int c = lane & 7;
#pragma unroll
    for (int j = 0; j < 4; ++j) { const int n = (lane >> 3) + 8 * j; const LAS float* s = scr + (8 * c) * 33 + n;
        u32x4 o; o.x = pk_h16(s[0 * 33], s[1 * 33]); o.y = pk_h16(s[2 * 33], s[3 * 33]); o.z = pk_h16(s[4 * 33], s[5 * 33]); o.w = pk_h16(s[6 * 33], s[7 * 33]);
        *(u32x4*)(WT + (size_t)(n0 + n) * K + k0 + 8 * c) = o; }
    asm volatile("s_waitcnt lgkmcnt(0)" ::: "memory");
}
__device__ __forceinline__ void phase0(const Ctx& C) {
    LAS float* scr = (LAS float*)(C.lds + C.wave * 16384);
    const int gw = C.vcu * NWAVES + C.wave, NGW = C.G * NWAVES;
    unsigned char* ws = C.ws;
    constexpr int I_HIN = (D / 64) * (N_HIN / 32), I_DD = (D / 64) * (D / 32), I_CIN = (D / 64) * (N_CIN / 32), I_W1 = (D / 64) * (FF / 32), I_W2 = (FF / 64) * (D / 32);
    constexpr int NITEMS = I_HIN + 2 * I_DD + I_CIN + 2 * I_W1 + 2 * I_W2;
    for (int it = gw; it < NITEMS; it += NGW) {
        int r = it;
        if (r < I_HIN) { p0_transpose_item(C.in[11], D, N_HIN, (h16*)(ws + WS_W_HIN), scr, r, C.lane); continue; } r -= I_HIN;
        if (r < I_DD) { p0_transpose_item(C.in[14], D, D, (h16*)(ws + WS_W_HOUT), scr, r, C.lane); continue; } r -= I_DD;
        if (r < I_CIN) { p0_transpose_item(C.in[15], D, N_CIN, (h16*)(ws + WS_W_CIN), scr, r, C.lane); continue; } r -= I_CIN;
        if (r < I_DD) { p0_transpose_item(C.in[20], D, D, (h16*)(ws + WS_W_COUT), scr, r, C.lane); continue; } r -= I_DD;
        if (r < 2 * I_W1) { const int l = r / I_W1; p0_transpose_item(C.in[9] + (size_t)l * D * FF, D, FF, (h16*)(ws + WS_W_W1 + (size_t)l * 8 * MiB), scr, r % I_W1, C.lane); continue; } r -= 2 * I_W1;
        { const int l = r / I_W2; p0_transpose_item(C.in[10] + (size_t)l * FF * D, FF, D, (h16*)(ws + WS_W_W2 + (size_t)l * 8 * MiB), scr, r % I_W2, C.lane); }
    }
    { const float* src = C.in[18]; h16* dst = (h16*)(ws + WS_W_WS);
      for (int i = (gw * 64 + C.lane) * 4; i < 8 * 128 * 128; i += NGW * 64 * 4) st_h16x4(dst + i, *(const f32x4*)(src + i)); }
    float* mod = C.ctlf + CW_MOD;
    for (int task = gw; task < 2 * 32 * 24; task += NGW) {
        const int l = task / (32 * 24), rem = task % (32 * 24), kc = rem / 24, cb = rem % 24;
        const int col = cb * 256 + C.lane * 4, k0 = kc * 32;
        const float* W = C.in[5] + (size_t)l * D * 6 * D;
        f32x4 acc[NCOND];
#pragma unroll
        for (int c = 0; c < NCOND; ++c) acc[c] = (f32x4){0.f, 0.f, 0.f, 0.f};
        for (int kk = 0; kk < 32; ++kk) {
            const f32x4 w = *(const f32x4*)(W + (size_t)(k0 + kk) * 6 * D + col);
#pragma unroll
            for (int c = 0; c < NCOND; ++c) { const float cv = (c == 0) ? C.in[4][k0 + kk] : C.in[3][(c - 1) * D + k0 + kk]; acc[c] += siluf_(cv) * w; }
        }
        if (kc == 0) { const f32x4 b = *(const f32x4*)(C.in[6] + (size_t)l * 6 * D + col);
#pragma unroll
            for (int c = 0; c < NCOND; ++c) acc[c] += b; }
#pragma unroll
        for (int c = 0; c < NCOND; ++c) { float* p = mod + ((size_t)l * NCOND + c) * 6 * D + col; atomicAdd(p, acc[c].x); atomicAdd(p + 1, acc[c].y); atomicAdd(p + 2, acc[c].z); atomicAdd(p + 3, acc[c].w); }
    }
}

__device__ __forceinline__ void phase1(const Ctx& C) {
    const int gw = C.vcu * NWAVES + C.wave, NGW = C.G * NWAVES, lane = C.lane;
    const float* mod = C.ctlf + CW_MOD; float* vec = C.vec; unsigned char* ws = C.ws;
    h16* AX = (h16*)(ws + WS_AX);
    const float* g0 = C.in[7];
    for (int row = gw; row < M; row += NGW) {
        const float* xr = row < M_CTX ? C.in[0] + (size_t)row * D : C.in[1] + (size_t)(row - M_CTX) * D;
        const float* mc = mod + (size_t)cond_of_row(row) * 6 * D;
        f32x4 v[4]; float s = 0.f;
#pragma unroll
        for (int j = 0; j < 4; ++j) { v[j] = *(const f32x4*)(xr + j * 256 + lane * 4); s += (v[j].x * v[j].x + v[j].y * v[j].y) + (v[j].z * v[j].z + v[j].w * v[j].w); }
        const float rstd = rsqrtf(wave_sum(s) * (1.0f / D) + EPS);
#pragma unroll
        for (int j = 0; j < 4; ++j) { const int col = j * 256 + lane * 4;
            const f32x4 g = *(const f32x4*)(g0 + col), sh = *(const f32x4*)(mc + col), sc = *(const f32x4*)(mc + D + col);
            st_h16x4(AX + (size_t)row * D + col, v[j] * rstd * g * (sc + 1.0f) + sh); }
    }
    for (int i = gw * 64 + lane; i < 3 * NCOND * D; i += NGW * 64) {
        const int vI = i / (NCOND * D), c = (i / D) % NCOND, col = i % D;
        const float g = vI == 0 ? C.in[8][col] : (vI == 1 ? C.in[7][D + col] : C.in[8][D + col]);
        const int l = vI == 0 ? 0 : 1, slot = vI == 1 ? 1 : 4;
        vec[VW_GN + i] = g * (1.0f + mod[((size_t)l * NCOND + c) * 6 * D + slot * D + col]);
    }
    for (int i = gw * 64 + lane; i < 2 * D; i += NGW * 64) { const float l0 = C.in[12][i], l1 = C.in[12][2 * D + i]; vec[VW_LB + i] = 1.0f / (1.0f + __expf(l1 - l0)); }
    constexpr int NB = 2 * FF + N_CIN;
    for (int task = gw; task < NB; task += NGW) {
        const h16* wrow; const float* sh; float* dst; int stride;
        if (task < FF) { wrow = (const h16*)(ws + WS_W_W1) + (size_t)task * D; sh = mod + 3 * D; dst = vec + VW_BMLP + task; stride = FF; }
        else if (task < 2 * FF) { const int n = task - FF; wrow = (const h16*)(ws + WS_W_W1 + 8 * MiB) + (size_t)n * D; sh = mod + (size_t)NCOND * 6 * D + 3 * D; dst = vec + VW_BMLP + NCOND * FF + n; stride = FF; }
        else { const int n = task - 2 * FF; wrow = (const h16*)(ws + WS_W_CIN) + (size_t)n * D; sh = mod + (size_t)NCOND * 6 * D; dst = vec + VW_BCM + n; stride = N_CIN; }
        float w[16];
        { const h16x8 a = *(const h16x8*)(wrow + lane * 8), b = *(const h16x8*)(wrow + 512 + lane * 8);
#pragma unroll
          for (int j = 0; j < 8; ++j) { w[j] = (float)a[j]; w[8 + j] = (float)b[j]; } }
#pragma unroll
        for (int c = 0; c < NCOND; ++c) { const float* s = sh + (size_t)c * 6 * D; float p = 0.f;
#pragma unroll
            for (int j = 0; j < 8; ++j) { p += w[j] * s[lane * 8 + j]; p += w[8 + j] * s[512 + lane * 8 + j]; }
            p = wave_sum(p); if (lane == 0) dst[(size_t)c * stride] = p; }
    }
}

__device__ __forceinline__ void naive_scan_phase(const Ctx& C) {
    LAS float* sf = (LAS float*)C.lds; LAS float* sk = sf + 8 * 128; LAS float* sq = sk + 8 * 128; LAS float* sv = sq + 8 * 128; LAS float* red = sv + 8 * 128;
    unsigned char* ws = C.ws; const int tid = C.tid;
    const h16* Q = (const h16*)(ws + WS_Q); const bf16_t* V = (const bf16_t*)(ws + WS_V);
    const h16* ZF = (const h16*)C.out; const h16* ZB = ZF + (size_t)M * D;
    const float* lbv = C.vec + VW_LB;
    const int kq = tid >> 7, vv = tid & 127;
    for (int item = C.vcu; item < 320; item += C.G) {
        int seq, h, dir;
        if (item < 64) { seq = 16 + item / 16; h = (item % 16) >> 1; dir = item & 1; } else { const int i2 = item - 64; seq = i2 / 16; h = (i2 % 16) >> 1; dir = i2 & 1; }
        const int L = seq < 16 ? 256 : 4096, row0 = seq < 16 ? seq * 256 : M_CTX + (seq - 16) * 4096;
        const h16* Z = dir ? ZB : ZF; h16* O = (h16*)(ws + (dir ? WS_AY : WS_AX));
        float S[32];
        if (seq < 16) {
#pragma unroll
            for (int i = 0; i < 32; ++i) S[i] = 0.f;
        } else { const float* s0 = C.in[2] + ((((size_t)(seq - 16) * 2 + dir) * NH + h) * HD) * HD;
#pragma unroll
            for (int i = 0; i < 32; ++i) S[i] = s0[(size_t)(kq * 32 + i) * HD + vv]; }
        for (int tb = 0; tb < L; tb += 8) {
            __syncthreads();
            if (tid < 128) { const float lb = lbv[dir * D + h * HD + tid];
#pragma unroll
                for (int j = 0; j < 8; ++j) { const int t = dir ? L - 1 - (tb + j) : tb + j; const size_t off = (size_t)(row0 + t) * D + h * HD + tid;
                    const float f = lb + (1.0f - lb) * sigmoidf_((float)Z[off]); sf[j * 128 + tid] = f; sk[j * 128 + tid] = 1.0f - f; sq[j * 128 + tid] = (float)Q[off]; }
            } else if (tid < 256) { const int c = tid - 128;
#pragma unroll
                for (int j = 0; j < 8; ++j) { const int t = dir ? L - 1 - (tb + j) : tb + j; sv[j * 128 + c] = bf2f(V[(size_t)(row0 + t) * D + h * HD + c]); }
            }
            __syncthreads();
#pragma unroll 1
            for (int j = 0; j < 8; ++j) { const float vval = sv[j * 128 + vv]; float part = 0.f;
#pragma unroll
                for (int i = 0; i < 32; ++i) { const int k = kq * 32 + i; S[i] = sf[j * 128 + k] * S[i] + sk[j * 128 + k] * vval; part += sq[j * 128 + k] * S[i]; }
                red[(kq * 8 + j) * 128 + vv] = part; }
            __syncthreads();
            if (tid < 128) {
#pragma unroll
                for (int j = 0; j < 8; ++j) { const int t = dir ? L - 1 - (tb + j) : tb + j;
                    const float o = (red[(0 * 8 + j) * 128 + tid] + red[(1 * 8 + j) * 128 + tid]) + (red[(2 * 8 + j) * 128 + tid] + red[(3 * 8 + j) * 128 + tid]);
                    O[(size_t)(row0 + t) * D + h * HD + tid] = (h16)o; }
            }
        }
        if (seq < 16) { float* so = C.out + (size_t)M * D + ((((size_t)seq * 2 + dir) * NH + h) * HD) * HD;
#pragma unroll
            for (int i = 0; i < 32; ++i) so[(size_t)(kq * 32 + i) * HD + vv] = S[i]; }
    }
    __syncthreads();
}
__device__ __forceinline__ void naive_combine_phase(const Ctx& C) {
    unsigned char* ws = C.ws; const int gw = C.vcu * NWAVES + C.wave, NGW = C.G * NWAVES, lane = C.lane;
    h16* AX = (h16*)(ws + WS_AX); const h16* AY = (const h16*)(ws + WS_AY); const h16* Gt = (const h16*)(ws + WS_G); const float* og = C.in[13];
    for (int task = gw; task < M * NH; task += NGW) {
        const int row = task >> 3, h = task & 7; const size_t off = (size_t)row * D + h * HD + lane * 2;
        const h16x2 a = *(const h16x2*)(AX + off), b = *(const h16x2*)(AY + off), g = *(const h16x2*)(Gt + off);
        const float o0 = (float)a.x + (float)b.x, o1 = (float)a.y + (float)b.y;
        const float r = rsqrtf(wave_sum(o0 * o0 + o1 * o1) * (1.0f / HD) + EPS);
        *(unsigned*)(AX + off) = pk_h16(o0 * r * og[h * HD + lane * 2] * (float)g.x, o1 * r * og[h * HD + lane * 2 + 1] * (float)g.y);
    }
}

__device__ __forceinline__ void naive_spatial_phase(const Ctx& C) {
    LAS float* As = (LAS float*)C.lds; LAS float* Bs = As + 16 * 132;
    unsigned char* ws = C.ws; const int tid = C.tid, ty = tid >> 5, tx = tid & 31;
    const h16* U = (const h16*)(ws + WS_U); const h16* V2 = (const h16*)(ws + WS_V2); const h16* Wsp = (const h16*)(ws + WS_W_WS); h16* AX = (h16*)(ws + WS_AX);
    const float* vs1 = C.ctlf + CW_VS1; const float* vs2 = C.ctlf + CW_VS2; const float* lng = C.in[16]; const float* lnb = C.in[17]; const float* bs = C.in[19];
    for (int item = C.vcu; item < (M / 128) * 8; item += C.G) {
        const int ch = item >> 3, g = item & 7, r0 = ch * 128;
        f32x4 acc[8];
#pragma unroll
        for (int i = 0; i < 8; ++i) acc[i] = (f32x4){0.f, 0.f, 0.f, 0.f};
        const int r = tid >> 2, kk = (tid & 3) * 4;
        for (int k0 = 0; k0 < 128; k0 += 16) {
            const h16x4 a = *(const h16x4*)(Wsp + ((size_t)g * 128 + r) * 128 + k0 + kk);
            const int qq = tid >> 5, c4 = (tid & 31) * 4, qrow = r0 + k0 + qq;
            const h16x4 vr = *(const h16x4*)(V2 + (size_t)qrow * D + g * 128 + c4);
            const float mu = vs1[qrow] * (1.0f / D), var = vs2[qrow] * (1.0f / D) - mu * mu, rs = rsqrtf(var + EPS);
            const f32x4 lg = *(const f32x4*)(lng + g * 128 + c4), lb = *(const f32x4*)(lnb + g * 128 + c4);
            f32x4 vn; vn.x = ((float)vr.x - mu) * rs * lg.x + lb.x; vn.y = ((float)vr.y - mu) * rs * lg.y + lb.y; vn.z = ((float)vr.z - mu) * rs * lg.z + lb.z; vn.w = ((float)vr.w - mu) * rs * lg.w + lb.w;
            __syncthreads();
#pragma unroll
            for (int j = 0; j < 4; ++j) As[(kk + j) * 132 + r] = (float)a[j];
            *(LAS f32x4*)(Bs + qq * 132 + c4) = vn;
            __syncthreads();
#pragma unroll 2
            for (int k = 0; k < 16; ++k) {
                const f32x4 a0 = *(LAS f32x4*)(As + k * 132 + ty * 8), a1 = *(LAS f32x4*)(As + k * 132 + ty * 8 + 4), bv = *(LAS f32x4*)(Bs + k * 132 + tx * 4);
                acc[0] += a0.x * bv; acc[1] += a0.y * bv; acc[2] += a0.z * bv; acc[3] += a0.w * bv;
                acc[4] += a1.x * bv; acc[5] += a1.y * bv; acc[6] += a1.z * bv; acc[7] += a1.w * bv;
            }
        }
#pragma unroll
        for (int i = 0; i < 8; ++i) { const int p = ty * 8 + i; const size_t off = (size_t)(r0 + p) * D + g * 128 + tx * 4;
            const h16x4 u = *(const h16x4*)(U + off); const float b = bs[g * 128 + p];
            f32x4 o; o.x = (float)u.x * (acc[i].x + b); o.y = (float)u.y * (acc[i].y + b); o.z = (float)u.z * (acc[i].z + b); o.w = (float)u.w * (acc[i].w + b);
            st_h16x4(AX + off, o); }
    }
    __syncthreads();
}

__device__ __forceinline__ void final_norm_phase(const Ctx& C) {
    const int gw = C.vcu * NWAVES + C.wave, NGW = C.G * NWAVES, lane = C.lane;
    const float* rsq = C.ctlf + CW_RSQ_D; const float* g = C.in[21];
    for (int row = gw; row < M; row += NGW) {
        const float rstd = rsqrtf(rsq[row] * (1.0f / D) + EPS); float* xr = C.out + (size_t)row * D;
#pragma unroll
        for (int j = 0; j < 4; ++j) { const int col = j * 256 + lane * 4; const f32x4 v = *(const f32x4*)(xr + col), gg = *(const f32x4*)(g + col); *(f32x4*)(xr + col) = v * rstd * gg; }
    }
}

__global__ void __launch_bounds__(NTHREADS, 2) fwd_kernel(Args args) {
    extern __shared__ __attribute__((aligned(16))) unsigned char lds_raw[];
    Ctx C;
    C.lds = (LAS unsigned char*)lds_raw;
    C.tid = threadIdx.x; C.lane = C.tid & 63; C.wave = __builtin_amdgcn_readfirstlane(C.tid >> 6);
    C.G = gridDim.x; { const int bx = blockIdx.x; C.vcu = (C.G % 8 == 0) ? (bx % 8) * (C.G / 8) + bx / 8 : bx; }
    C.in = args.in; C.out = args.out; C.ws = args.ws;
    C.ctlf = (float*)(args.ws + WS_CTL); C.vec = (float*)(args.ws + WS_VEC);
    unsigned char* ws = args.ws;
    const int lo = args.ph_lo, hi = args.ph_hi;
    float* mod = C.ctlf + CW_MOD;
    h16* AX = (h16*)(ws + WS_AX); h16* AY = (h16*)(ws + WS_AY); h16* HID = (h16*)(ws + WS_HID);
#define IN(k) (lo <= (k) && (k) < hi)
#define SEAM(k) do { } while (0)
    if (IN(0)) { phase0(C); SEAM(0); }
    if (IN(1)) { phase1(C); SEAM(1); }
    if (IN(2)) { EpiWin E{(h16*)(ws + WS_Q), (h16*)C.out, (h16*)C.out + (size_t)M * D, (bf16_t*)(ws + WS_V), (h16*)(ws + WS_G)};
        naive_gemm_phase(C, AX, (const h16*)(ws + WS_W_HIN), M, N_HIN, D, E); SEAM(2); }
    if (IN(3)) { naive_scan_phase(C); SEAM(3); }
    if (IN(4)) { naive_combine_phase(C); SEAM(4); }
    if (IN(5)) { EpiRes E{C.in[0], C.in[1], C.out, mod + 2 * D, C.vec + VW_GN, AY, C.ctlf + CW_RSQ_A};
        naive_gemm_phase(C, AX, (const h16*)(ws + WS_W_HOUT), M, D, D, E); SEAM(5); }
    if (IN(6)) { EpiHid E{C.ctlf + CW_RSQ_A, C.vec + VW_BMLP, HID};
        naive_gemm_phase(C, AY, (const h16*)(ws + WS_W_W1), M, FF, D, E); SEAM(6); }
    if (IN(7)) { EpiRes E{nullptr, nullptr, C.out, mod + 5 * D, C.vec + VW_GN + NCOND * D, AY, C.ctlf + CW_RSQ_B};
        naive_gemm_phase(C, HID, (const h16*)(ws + WS_W_W2), M, D, FF, E); SEAM(7); }
    if (IN(8)) { EpiCin E{C.ctlf + CW_RSQ_B, C.vec + VW_BCM, (h16*)(ws + WS_U), (h16*)(ws + WS_V2), C.ctlf + CW_VS1, C.ctlf + CW_VS2};
        naive_gemm_phase(C, AY, (const h16*)(ws + WS_W_CIN), M, N_CIN, D, E); SEAM(8); }
    if (IN(9)) { naive_spatial_phase(C); SEAM(9); }
    if (IN(10)) { EpiRes E{nullptr, nullptr, C.out, mod + (size_t)NCOND * 6 * D + 2 * D, C.vec + VW_GN + 2 * NCOND * D, AY, C.ctlf + CW_RSQ_C};
        naive_gemm_phase(C, AX, (const h16*)(ws + WS_W_COUT), M, D, D, E); SEAM(10); }
    if (IN(11)) { EpiHid E{C.ctlf + CW_RSQ_C, C.vec + VW_BMLP + NCOND * FF, HID};
        naive_gemm_phase(C, AY, (const h16*)(ws + WS_W_W1 + 8 * MiB), M, FF, D, E); SEAM(11); }
    if (IN(12)) { EpiRes E{nullptr, nullptr, C.out, mod + (size_t)NCOND * 6 * D + 5 * D, nullptr, nullptr, C.ctlf + CW_RSQ_D};
        naive_gemm_phase(C, HID, (const h16*)(ws + WS_W_W2 + 8 * MiB), M, D, FF, E); SEAM(12); }
    if (IN(13)) { final_norm_phase(C); }
#undef IN
#undef SEAM
}

constexpr int LDS_BYTES = 147456;
extern "C" void kernel_launch(void* const* d_in, const int* in_sizes, int n_in, void* d_out, int out_size, void* d_ws, size_t ws_size, hipStream_t stream) {
    static int grid = 0;
    if (grid == 0) {
        if (n_in != 22 || ws_size < WS_END) { fprintf(stderr, "kernel_launch: unexpected shapes (n_in %d, ws %zu)\n", n_in, ws_size); grid = -1; return; }
        int dev = 0, cus = 0;
        if (hipGetDevice(&dev) != hipSuccess || hipDeviceGetAttribute(&cus, hipDeviceAttributeMultiprocessorCount, dev) != hipSuccess) { grid = -1; return; }
        if (hipFuncSetAttribute((const void*)fwd_kernel, hipFuncAttributeMaxDynamicSharedMemorySize, LDS_BYTES) != hipSuccess) { fprintf(stderr, "kernel_launch: hipFuncSetAttribute failed\n"); grid = -1; return; }
        grid = cus;
    }
    if (grid < 0) return;
    (void)hipMemsetAsync((char*)d_ws + WS_CTL, 0, CTL_ZERO_BYTES, stream);
    Args a{};
    for (int i = 0; i < 22; ++i) a.in[i] = (const float*)d_in[i];
    a.out = (float*)d_out; a.ws = (unsigned char*)d_ws;
#if MK_LAUNCH_PER_PHASE
    for (int p = 0; p < NPHASES; ++p) { a.ph_lo = p; a.ph_hi = p + 1; hipLaunchKernelGGL(fwd_kernel, dim3(grid), dim3(NTHREADS), LDS_BYTES, stream, a); }
#else
    a.ph_lo = 0; a.ph_hi = NPHASES; hipLaunchKernelGGL(fwd_kernel, dim3(grid), dim3(NTHREADS), LDS_BYTES, stream, a);
#endif
}
```

```cpp
#include <hip/hip_runtime.h>
#include <cstdio>
#include <cstdint>

#ifndef MK_LAUNCH_PER_PHASE
#define MK_LAUNCH_PER_PHASE 0
#endif

#define GAS __attribute__((address_space(1)))
#define LAS __attribute__((address_space(3)))
typedef _Float16 h16;
typedef _Float16 h16x2 __attribute__((ext_vector_type(2)));
typedef _Float16 h16x4 __attribute__((ext_vector_type(4)));
typedef _Float16 h16x8 __attribute__((ext_vector_type(8)));
typedef float f32x2 __attribute__((ext_vector_type(2)));
typedef float f32x4 __attribute__((ext_vector_type(4)));
typedef unsigned u32x2 __attribute__((ext_vector_type(2)));
typedef unsigned u32x4 __attribute__((ext_vector_type(4)));
typedef unsigned short bf16_t;
typedef __bf16 bf16x2_t __attribute__((ext_vector_type(2)));

constexpr int D = 1024, M_CTX = 4096, M_LAT = 16384, M = M_CTX + M_LAT, FF = 4096, NCOND = 5, NH = 8, HD = 128;
constexpr int N_HIN = 5 * D, N_CIN = 2 * D;
constexpr float EPS = 1e-6f;
constexpr int NWAVES = 8, NTHREADS = 512, NPHASES = 14;
constexpr int LDS_BYTES = 147456, MISC_OFF = 131072 + 320;

constexpr size_t MiB = 1u << 20;
constexpr size_t WS_CTL = 0, CTL_ZERO_BYTES = 1 * MiB;
constexpr int CW_TMO = 0, CW_BAR = 1024, CW_MOD = 8192, CW_RSQ_A = CW_MOD + 2 * NCOND * 6 * D, CW_RSQ_B = CW_RSQ_A + M, CW_RSQ_C = CW_RSQ_B + M,
              CW_RSQ_D = CW_RSQ_C + M, CW_VS1 = CW_RSQ_D + M, CW_VS2 = CW_VS1 + M, CW_END = CW_VS2 + M;
static_assert((size_t)CW_END * 4 <= CTL_ZERO_BYTES, "ctl words");
constexpr size_t WS_VEC = 1 * MiB;
constexpr int VW_GN = 0  , VW_BMLP = VW_GN + 3 * NCOND * D  , VW_BCM = VW_BMLP + 2 * NCOND * FF  , VW_LB = VW_BCM + NCOND * N_CIN  , VW_END = VW_LB + 2 * D;
static_assert((size_t)VW_END * 4 <= MiB, "vec words");
constexpr size_t WS_W_HIN = 2 * MiB, WS_W_HOUT = 12 * MiB, WS_W_CIN = 14 * MiB, WS_W_COUT = 18 * MiB, WS_W_W1 = 20 * MiB  , WS_W_W2 = 36 * MiB  , WS_W_WS = 52 * MiB;
constexpr size_t WS_AY = 54 * MiB, WS_AX = 94 * MiB, WS_Q = 134 * MiB, WS_V = 174 * MiB, WS_G = 214 * MiB, WS_END = 254 * MiB;
constexpr size_t WS_HID = WS_AX;
constexpr size_t WS_U = WS_Q, WS_V2 = WS_V;
constexpr size_t ACT_BYTES = (size_t)M * D * 2;
static_assert(ACT_BYTES == 40 * MiB && WS_HID + (size_t)M * FF * 2 == WS_END, "map");

__device__ __forceinline__ float ex2(float x) { return __builtin_amdgcn_exp2f(x); }
__device__ __forceinline__ float rcpf(float x) { return __builtin_amdgcn_rcpf(x); }
__device__ __forceinline__ float sigmoidf_(float x) { return rcpf(1.0f + ex2(-1.4426950408889634f * x)); }
__device__ __forceinline__ float siluf_(float x) { return x * sigmoidf_(x); }
__device__ __forceinline__ float gelu_tanh(float x) { const float y = 0.7978845608028654f * (x + 0.044715f * x * x * x); const float t = 1.0f - 2.0f * rcpf(1.0f + ex2(2.885390081777927f * y)); return 0.5f * x * (1.0f + t); }
__device__ __forceinline__ float bf2f(bf16_t b) { return __uint_as_float((unsigned)b << 16); }
__device__ __forceinline__ unsigned pk_bf16(float lo, float hi) { f32x2 v = {lo, hi}; bf16x2_t b = __builtin_convertvector(v, bf16x2_t); return __builtin_bit_cast(unsigned, b); }
__device__ __forceinline__ unsigned pk_h16(float lo, float hi) { f32x2 v = {lo, hi}; h16x2 b = __builtin_convertvector(v, h16x2); return __builtin_bit_cast(unsigned, b); }
__device__ __forceinline__ void st_h16x4(h16* p, f32x4 v) { u32x2 w; w.x = pk_h16(v.x, v.y); w.y = pk_h16(v.z, v.w); *(u32x2*)p = w; }
__device__ __forceinline__ void st_bf16x4(bf16_t* p, f32x4 v) { u32x2 w; w.x = pk_bf16(v.x, v.y); w.y = pk_bf16(v.z, v.w); *(u32x2*)p = w; }
__device__ __forceinline__ float wave_sum(float v) {
#pragma unroll
    for (int o = 1; o < 64; o <<= 1) v += __shfl_xor(v, o);
    return v;
}
__device__ __forceinline__ int cond_of_row(int row) { return row < M_CTX ? 0 : 1 + ((row - M_CTX) >> 12); }

struct Args { const float* in[22]; float* out; unsigned char* ws; int ph_lo, ph_hi; };

struct Ctx {
    LAS unsigned char* lds;
    int tid, lane, wave, vcu, G;
    const float* const* in; float* out; unsigned char* ws;
    float* ctlf; float* vec;
};

struct EpiWin {
    static constexpr bool STATS = false;
    h16* Q; h16* ZF; h16* ZB; bf16_t* V; h16* Gt;
    __device__ __forceinline__ void apply(int row, int col, f32x4 a, float&, float&) const {
        const int grp = col >> 10, cc = col & 1023; const size_t off = (size_t)row * D + cc;
        if (grp == 0) { f32x4 s = {siluf_(a.x), siluf_(a.y), siluf_(a.z), siluf_(a.w)}; st_h16x4(Q + off, s); }
        else if (grp == 1) st_h16x4(ZF + off, a);
        else if (grp == 2) st_h16x4(ZB + off, a);
        else if (grp == 3) st_bf16x4(V + off, a);
        else { f32x4 s = {siluf_(a.x), siluf_(a.y), siluf_(a.z), siluf_(a.w)}; st_h16x4(Gt + off, s); }
    }
    __device__ __forceinline__ void commit(int, int, float, float) const {}
};
struct EpiRes {
    static constexpr bool STATS = true;
    const float* xp; const float* xs;
    float* out; const float* gate;
    const float* gn; h16* Aout;
    float* rsq;
    __device__ __forceinline__ void apply(int row, int col, f32x4 a, float&, float& s2) const {
        const int cond = cond_of_row(row); const size_t off = (size_t)row * D + col;
        const float* xo = xp ? (row < M_CTX ? xp + off : xs + (off - (size_t)M_CTX * D)) : out + off;
        const f32x4 x0 = *(const f32x4*)xo, g = *(const f32x4*)(gate + cond * 6 * D + col);
        const f32x4 xn = x0 + g * a;
        *(f32x4*)(out + off) = xn;
        s2 += (xn.x * xn.x + xn.y * xn.y) + (xn.z * xn.z + xn.w * xn.w);
        if (Aout) { const f32x4 gv = *(const f32x4*)(gn + cond * D + col); st_h16x4(Aout + off, xn * gv); }
    }
    __device__ __forceinline__ void commit(int row, int, float, float s2) const { atomicAdd(rsq + row, s2); }
};
struct EpiHid {
    static constexpr bool STATS = false;
    const float* rsq; const float* bias; h16* H;
    __device__ __forceinline__ void apply(int row, int col, f32x4 a, float&, float&) const {
        const int cond = cond_of_row(row); const float rstd = rsqrtf(rsq[row] * (1.0f / D) + EPS);
        const f32x4 b = *(const f32x4*)(bias + cond * FF + col);
        f32x4 z = a * rstd + b; z.x = fmaxf(z.x, 0.f); z.y = fmaxf(z.y, 0.f); z.z = fmaxf(z.z, 0.f); z.w = fmaxf(z.w, 0.f);
        st_h16x4(H + (size_t)row * FF + col, z * z);
    }
    __device__ __forceinline__ void commit(int, int, float, float) const {}
};
struct EpiCin {
    static constexpr bool STATS = true;
    const float* rsq; const float* bias; h16* U; h16* V2; float* vs1; float* vs2;
    __device__ __forceinline__ void apply(int row, int col, f32x4 a, float& s1, float& s2) const {
        const int cond = cond_of_row(row); const float rstd = rsqrtf(rsq[row] * (1.0f / D) + EPS);
        const f32x4 b = *(const f32x4*)(bias + cond * N_CIN + col);
        f32x4 z = a * rstd + b; z.x = gelu_tanh(z.x); z.y = gelu_tanh(z.y); z.z = gelu_tanh(z.z); z.w = gelu_tanh(z.w);
        if (col < D) st_h16x4(U + (size_t)row * D + col, z);
        else { st_h16x4(V2 + (size_t)row * D + (col - D), z); s1 += (z.x + z.y) + (z.z + z.w); s2 += (z.x * z.x + z.y * z.y) + (z.z * z.z + z.w * z.w); }
    }
    __device__ __forceinline__ void commit(int row, int col, float s1, float s2) const { if (col >= D) { atomicAdd(vs1 + row, s1); atomicAdd(vs2 + row, s2); } }
};

template <class Epi>
__device__ __forceinline__ void naive_gemm_phase(const Ctx& C, const h16* A, const h16* Wt, int Mr, int N, int K, const Epi& E) {
    LAS float* As = (LAS float*)C.lds; LAS float* Bs = As + 16 * 132;
    const int tid = C.tid, ty = tid >> 5, tx = tid & 31;
    const int ntn = N / 128, ntiles = (Mr / 128) * ntn;
    for (int t = C.vcu; t < ntiles; t += C.G) {
        const int pm = t / ntn, pn = t % ntn;
        f32x4 acc[8];
#pragma unroll
        for (int i = 0; i < 8; ++i) acc[i] = (f32x4){0.f, 0.f, 0.f, 0.f};
        const int r = tid >> 2, kk = (tid & 3) * 4;
        const h16* ap = A + (size_t)(pm * 128 + r) * K + kk; const h16* bp = Wt + (size_t)(pn * 128 + r) * K + kk;
        for (int k0 = 0; k0 < K; k0 += 16) {
            const h16x4 a = *(const h16x4*)(ap + k0), b = *(const h16x4*)(bp + k0);
            __syncthreads();
#pragma unroll
            for (int j = 0; j < 4; ++j) { As[(kk + j) * 132 + r] = (float)a[j]; Bs[(kk + j) * 132 + r] = (float)b[j]; }
            __syncthreads();
#pragma unroll 2
            for (int k = 0; k < 16; ++k) {
                const f32x4 a0 = *(LAS f32x4*)(As + k * 132 + ty * 8), a1 = *(LAS f32x4*)(As + k * 132 + ty * 8 + 4), bv = *(LAS f32x4*)(Bs + k * 132 + tx * 4);
                acc[0] += a0.x * bv; acc[1] += a0.y * bv; acc[2] += a0.z * bv; acc[3] += a0.w * bv;
                acc[4] += a1.x * bv; acc[5] += a1.y * bv; acc[6] += a1.z * bv; acc[7] += a1.w * bv;
            }
        }
#pragma unroll
        for (int i = 0; i < 8; ++i) { float s1 = 0.f, s2 = 0.f; const int row = pm * 128 + ty * 8 + i, col = pn * 128 + tx * 4; E.apply(row, col, acc[i], s1, s2); E.commit(row, col, s1, s2); }
    }
    __syncthreads();
}

__device__ __forceinline__ void p0_transpose_item(const float* W, int K, int N, h16* WT, LAS float* scr, int item, int lane) {
    const int nblk = N / 32, kb = item / nblk, nb = item % nblk, k0 = 64 * kb, n0 = 32 * nb;
#pragma unroll 8
    for (int i = 0; i < 32; ++i) { const int kk = 2 * i + (lane >> 5); scr[kk * 33 + (lane & 31)] = W[(size_t)(k0 + kk) * N + n0 + (lane & 31)]; }
    asm volatile("s_waitcnt lgkmcnt(0)" ::: "memory");
    const int c = lane & 7;
#pragma unroll
    for (int j = 0; j < 4; ++j) { const int n = (lane >> 3) + 8 * j; const LAS float* s = scr + (8 * c) * 33 + n;
        u32x4 o; o.x = pk_h16(s[0 * 33], s[1 * 33]); o.y = pk_h16(s[2 * 33], s[3 * 33]); o.z = pk_h16(s[4 * 33], s[5 * 33]); o.w = pk_h16(s[6 * 33], s[7 * 33]);
        *(u32x4*)(WT + (size_t)(n0 + n) * K + k0 + 8 * c) = o; }
    asm volatile("s_waitcnt lgkmcnt(0)" ::: "memory");
}
__device__ __forceinline__ void phase0(const Ctx& C) {
    LAS float* scr = (LAS float*)(C.lds + C.wave * 16384);
    const int gw = C.vcu * NWAVES + C.wave, NGW = C.G * NWAVES;
    unsigned char* ws = C.ws;
    constexpr int I_HIN = (D / 64) * (N_HIN / 32), I_DD = (D / 64) * (D / 32), I_CIN = (D / 64) * (N_CIN / 32), I_W1 = (D / 64) * (FF / 32), I_W2 = (FF / 64) * (D / 32);
    constexpr int NITEMS = I_HIN + 2 * I_DD + I_CIN + 2 * I_W1 + 2 * I_W2;
    for (int it = gw; it < NITEMS; it += NGW) {
        int r = it;
        if (r < I_HIN) { p0_transpose_item(C.in[11], D, N_HIN, (h16*)(ws + WS_W_HIN), scr, r, C.lane); continue; } r -= I_HIN;
        if (r < I_DD) { p0_transpose_item(C.in[14], D, D, (h16*)(ws + WS_W_HOUT), scr, r, C.lane); continue; } r -= I_DD;
        if (r < I_CIN) { p0_transpose_item(C.in[15], D, N_CIN, (h16*)(ws + WS_W_CIN), scr, r, C.lane); continue; } r -= I_CIN;
        if (r < I_DD) { p0_transpose_item(C.in[20], D, D, (h16*)(ws + WS_W_COUT), scr, r, C.lane); continue; } r -= I_DD;
        if (r < 2 * I_W1) { const int l = r / I_W1; p0_transpose_item(C.in[9] + (size_t)l * D * FF, D, FF, (h16*)(ws + WS_W_W1 + (size_t)l * 8 * MiB), scr, r % I_W1, C.lane); continue; } r -= 2 * I_W1;
        { const int l = r / I_W2; p0_transpose_item(C.in[10] + (size_t)l * FF * D, FF, D, (h16*)(ws + WS_W_W2 + (size_t)l * 8 * MiB), scr, r % I_W2, C.lane); }
    }
    { const float* src = C.in[18]; h16* dst = (h16*)(ws + WS_W_WS);
      for (int i = (gw * 64 + C.lane) * 4; i < 8 * 128 * 128; i += NGW * 64 * 4) st_h16x4(dst + i, *(const f32x4*)(src + i)); }
    float* mod = C.ctlf + CW_MOD;
    for (int task = gw; task < 2 * 32 * 24; task += NGW) {
        const int l = task / (32 * 24), rem = task % (32 * 24), kc = rem / 24, cb = rem % 24;
        const int col = cb * 256 + C.lane * 4, k0 = kc * 32;
        const float* W = C.in[5] + (size_t)l * D * 6 * D;
        f32x4 acc[NCOND];
#pragma unroll
        for (int c = 0; c < NCOND; ++c) acc[c] = (f32x4){0.f, 0.f, 0.f, 0.f};
        for (int kk = 0; kk < 32; ++kk) {
            const f32x4 w = *(const f32x4*)(W + (size_t)(k0 + kk) * 6 * D + col);
#pragma unroll
            for (int c = 0; c < NCOND; ++c) { const float cv = (c == 0) ? C.in[4][k0 + kk] : C.in[3][(c - 1) * D + k0 + kk]; acc[c] += siluf_(cv) * w; }
        }
        if (kc == 0) { const f32x4 b = *(const f32x4*)(C.in[6] + (size_t)l * 6 * D + col);
#pragma unroll
            for (int c = 0; c < NCOND; ++c) acc[c] += b; }
#pragma unroll
        for (int c = 0; c < NCOND; ++c) { float* p = mod + ((size_t)l * NCOND + c) * 6 * D + col; atomicAdd(p, acc[c].x); atomicAdd(p + 1, acc[c].y); atomicAdd(p + 2, acc[c].z); atomicAdd(p + 3, acc[c].w); }
    }
}

__device__ __forceinline__ void phase1(const Ctx& C) {
    const int gw = C.vcu * NWAVES + C.wave, NGW = C.G * NWAVES, lane = C.lane;
    const float* mod = C.ctlf + CW_MOD; float* vec = C.vec; unsigned char* ws = C.ws;
    h16* AX = (h16*)(ws + WS_AX);
    const float* g0 = C.in[7];
    for (int row = gw; row < M; row += NGW) {
        const float* xr = row < M_CTX ? C.in[0] + (size_t)row * D : C.in[1] + (size_t)(row - M_CTX) * D;
        const float* mc = mod + (size_t)cond_of_row(row) * 6 * D;
        f32x4 v[4]; float s = 0.f;
#pragma unroll
        for (int j = 0; j < 4; ++j) { v[j] = *(const f32x4*)(xr + j * 256 + lane * 4); s += (v[j].x * v[j].x + v[j].y * v[j].y) + (v[j].z * v[j].z + v[j].w * v[j].w); }
        const float rstd = rsqrtf(wave_sum(s) * (1.0f / D) + EPS);
#pragma unroll
        for (int j = 0; j < 4; ++j) { const int col = j * 256 + lane * 4;
            const f32x4 g = *(const f32x4*)(g0 + col), sh = *(const f32x4*)(mc + col), sc = *(const f32x4*)(mc + D + col);
            st_h16x4(AX + (size_t)row * D + col, v[j] * rstd * g * (sc + 1.0f) + sh); }
    }
    for (int i = gw * 64 + lane; i < 3 * NCOND * D; i += NGW * 64) {
        const int vI = i / (NCOND * D), c = (i / D) % NCOND, col = i % D;
        const float g = vI == 0 ? C.in[8][col] : (vI == 1 ? C.in[7][D + col] : C.in[8][D + col]);
        const int l = vI == 0 ? 0 : 1, slot = vI == 1 ? 1 : 4;
        vec[VW_GN + i] = g * (1.0f + mod[((size_t)l * NCOND + c) * 6 * D + slot * D + col]);
    }
    for (int i = gw * 64 + lane; i < 2 * D; i += NGW * 64) { const float l0 = C.in[12][i], l1 = C.in[12][2 * D + i]; vec[VW_LB + i] = 1.0f / (1.0f + __expf(l1 - l0)); }
    constexpr int NB = 2 * FF + N_CIN;
    for (int task = gw; task < NB; task += NGW) {
        const h16* wrow; const float* sh; float* dst; int stride;
        if (task < FF) { wrow = (const h16*)(ws + WS_W_W1) + (size_t)task * D; sh = mod + 3 * D; dst = vec + VW_BMLP + task; stride = FF; }
        else if (task < 2 * FF) { const int n = task - FF; wrow = (const h16*)(ws + WS_W_W1 + 8 * MiB) + (size_t)n * D; sh = mod + (size_t)NCOND * 6 * D + 3 * D; dst = vec + VW_BMLP + NCOND * FF + n; stride = FF; }
        else { const int n = task - 2 * FF; wrow = (const h16*)(ws + WS_W_CIN) + (size_t)n * D; sh = mod + (size_t)NCOND * 6 * D; dst = vec + VW_BCM + n; stride = N_CIN; }
        float w[16];
        { const h16x8 a = *(const h16x8*)(wrow + lane * 8), b = *(const h16x8*)(wrow + 512 + lane * 8);
#pragma unroll
          for (int j = 0; j < 8; ++j) { w[j] = (float)a[j]; w[8 + j] = (float)b[j]; } }
#pragma unroll
        for (int c = 0; c < NCOND; ++c) { const float* s = sh + (size_t)c * 6 * D; float p = 0.f;
#pragma unroll
            for (int j = 0; j < 8; ++j) { p += w[j] * s[lane * 8 + j]; p += w[8 + j] * s[512 + lane * 8 + j]; }
            p = wave_sum(p); if (lane == 0) dst[(size_t)c * stride] = p; }
    }
}

__device__ __forceinline__ void naive_scan_phase(const Ctx& C) {
    LAS float* sf = (LAS float*)C.lds; LAS float* sk = sf + 8 * 128; LAS float* sq = sk + 8 * 128; LAS float* sv = sq + 8 * 128; LAS float* red = sv + 8 * 128;
    unsigned char* ws = C.ws; const int tid = C.tid;
    const h16* Q = (const h16*)(ws + WS_Q); const bf16_t* V = (const bf16_t*)(ws + WS_V);
    const h16* ZF = (const h16*)C.out; const h16* ZB = ZF + (size_t)M * D;
    const float* lbv = C.vec + VW_LB;
    const int kq = tid >> 7, vv = tid & 127;
    for (int item = C.vcu; item < 320; item += C.G) {
        int seq, h, dir;
        if (item < 64) { seq = 16 + item / 16; h = (item % 16) >> 1; dir = item & 1; } else { const int i2 = item - 64; seq = i2 / 16; h = (i2 % 16) >> 1; dir = i2 & 1; }
        const int L = seq < 16 ? 256 : 4096, row0 = seq < 16 ? seq * 256 : M_CTX + (seq - 16) * 4096;
        const h16* Z = dir ? ZB : ZF; h16* O = (h16*)(ws + (dir ? WS_AY : WS_AX));
        float S[32];
        if (seq < 16) {
#pragma unroll
            for (int i = 0; i < 32; ++i) S[i] = 0.f;
        } else { const float* s0 = C.in[2] + ((((size_t)(seq - 16) * 2 + dir) * NH + h) * HD) * HD;
#pragma unroll
            for (int i = 0; i < 32; ++i) S[i] = s0[(size_t)(kq * 32 + i) * HD + vv]; }
        for (int tb = 0; tb < L; tb += 8) {
            __syncthreads();
            if (tid < 128) { const float lb = lbv[dir * D + h * HD + tid];
#pragma unroll
                for (int j = 0; j < 8; ++j) { const int t = dir ? L - 1 - (tb + j) : tb + j; const size_t off = (size_t)(row0 + t) * D + h * HD + tid;
                    const float f = lb + (1.0f - lb) * sigmoidf_((float)Z[off]); sf[j * 128 + tid] = f; sk[j * 128 + tid] = 1.0f - f; sq[j * 128 + tid] = (float)Q[off]; }
            } else if (tid < 256) { const int c = tid - 128;
#pragma unroll
                for (int j = 0; j < 8; ++j) { const int t = dir ? L - 1 - (tb + j) : tb + j; sv[j * 128 + c] = bf2f(V[(size_t)(row0 + t) * D + h * HD + c]); }
            }
            __syncthreads();
#pragma unroll 1
            for (int j = 0; j < 8; ++j) { const float vval = sv[j * 128 + vv]; float part = 0.f;
#pragma unroll
                for (int i = 0; i < 32; ++i) { const int k = kq * 32 + i; S[i] = sf[j * 128 + k] * S[i] + sk[j * 128 + k] * vval; part += sq[j * 128 + k] * S[i]; }
                red[(kq * 8 + j) * 128 + vv] = part; }
            __syncthreads();
            if (tid < 128) {
#pragma unroll
                for (int j = 0; j < 8; ++j) { const int t = dir ? L - 1 - (tb + j) : tb + j;
                    const float o = (red[(0 * 8 + j) * 128 + tid] + red[(1 * 8 + j) * 128 + tid]) + (red[(2 * 8 + j) * 128 + tid] + red[(3 * 8 + j) * 128 + tid]);
                    O[(size_t)(row0 + t) * D + h * HD + tid] = (h16)o; }
            }
        }
        if (seq < 16) { float* so = C.out + (size_t)M * D + ((((size_t)seq * 2 + dir) * NH + h) * HD) * HD;
#pragma unroll
            for (int i = 0; i < 32; ++i) so[(size_t)(kq * 32 + i) * HD + vv] = S[i]; }
    }
    __syncthreads();
}
__device__ __forceinline__ void naive_combine_phase(const Ctx& C) {
    unsigned char* ws = C.ws; const int gw = C.vcu * NWAVES + C.wave, NGW = C.G * NWAVES, lane = C.lane;
    h16* AX = (h16*)(ws + WS_AX); const h16* AY = (const h16*)(ws + WS_AY); const h16* Gt = (const h16*)(ws + WS_G); const float* og = C.in[13];
    for (int task = gw; task < M * NH; task += NGW) {
        const int row = task >> 3, h = task & 7; const size_t off = (size_t)row * D + h * HD + lane * 2;
        const h16x2 a = *(const h16x2*)(AX + off), b = *(const h16x2*)(AY + off), g = *(const h16x2*)(Gt + off);
        const float o0 = (float)a.x + (float)b.x, o1 = (float)a.y + (float)b.y;
        const float r = rsqrtf(wave_sum(o0 * o0 + o1 * o1) * (1.0f / HD) + EPS);
        *(unsigned*)(AX + off) = pk_h16(o0 * r * og[h * HD + lane * 2] * (float)g.x, o1 * r * og[h * HD + lane * 2 + 1] * (float)g.y);
    }
}

__device__ __forceinline__ void naive_spatial_phase(const Ctx& C) {
    LAS float* As = (LAS float*)C.lds; LAS float* Bs = As + 16 * 132;
    unsigned char* ws = C.ws; const int tid = C.tid, ty = tid >> 5, tx = tid & 31;
    const h16* U = (const h16*)(ws + WS_U); const h16* V2 = (const h16*)(ws + WS_V2); const h16* Wsp = (const h16*)(ws + WS_W_WS); h16* AX = (h16*)(ws + WS_AX);
    const float* vs1 = C.ctlf + CW_VS1; const float* vs2 = C.ctlf + CW_VS2; const float* lng = C.in[16]; const float* lnb = C.in[17]; const float* bs = C.in[19];
    for (int item = C.vcu; item < (M / 128) * 8; item += C.G) {
        const int ch = item >> 3, g = item & 7, r0 = ch * 128;
        f32x4 acc[8];
#pragma unroll
        for (int i = 0; i < 8; ++i) acc[i] = (f32x4){0.f, 0.f, 0.f, 0.f};
        const int r = tid >> 2, kk = (tid & 3) * 4;
        for (int k0 = 0; k0 < 128; k0 += 16) {
            const h16x4 a = *(const h16x4*)(Wsp + ((size_t)g * 128 + r) * 128 + k0 + kk);
            const int qq = tid >> 5, c4 = (tid & 31) * 4, qrow = r0 + k0 + qq;
            const h16x4 vr = *(const h16x4*)(V2 + (size_t)qrow * D + g * 128 + c4);
            const float mu = vs1[qrow] * (1.0f / D), var = vs2[qrow] * (1.0f / D) - mu * mu, rs = rsqrtf(var + EPS);
            const f32x4 lg = *(const f32x4*)(lng + g * 128 + c4), lb = *(const f32x4*)(lnb + g * 128 + c4);
            f32x4 vn; vn.x = ((float)vr.x - mu) * rs * lg.x + lb.x; vn.y = ((float)vr.y - mu) * rs * lg.y + lb.y; vn.z = ((float)vr.z - mu) * rs * lg.z + lb.z; vn.w = ((float)vr.w - mu) * rs * lg.w + lb.w;
            __syncthreads();
#pragma unroll
            for (int j = 0; j < 4; ++j) As[(kk + j) * 132 + r] = (float)a[j];
            *(LAS f32x4*)(Bs + qq * 132 + c4) = vn;
            __syncthreads();
#pragma unroll 2
            for (int k = 0; k < 16; ++k) {
                const f32x4 a0 = *(LAS f32x4*)(As + k * 132 + ty * 8), a1 = *(LAS f32x4*)(As + k * 132 + ty * 8 + 4), bv = *(LAS f32x4*)(Bs + k * 132 + tx * 4);
                acc[0] += a0.x * bv; acc[1] += a0.y * bv; acc[2] += a0.z * bv; acc[3] += a0.w * bv;
                acc[4] += a1.x * bv; acc[5] += a1.y * bv; acc[6] += a1.z * bv; acc[7] += a1.w * bv;
            }
        }
#pragma unroll
        for (int i = 0; i < 8; ++i) { const int p = ty * 8 + i; const size_t off = (size_t)(r0 + p) * D + g * 128 + tx * 4;
            const h16x4 u = *(const h16x4*)(U + off); const float b = bs[g * 128 + p];
            f32x4 o; o.x = (float)u.x * (acc[i].x + b); o.y = (float)u.y * (acc[i].y + b); o.z = (float)u.z * (acc[i].z + b); o.w = (float)u.w * (acc[i].w + b);
            st_h16x4(AX + off, o); }
    }
    __syncthreads();
}

__device__ __forceinline__ void final_norm_phase(const Ctx& C) {
    const int gw = C.vcu * NWAVES + C.wave, NGW = C.G * NWAVES, lane = C.lane;
    const float* rsq = C.ctlf + CW_RSQ_D; const float* g = C.in[21];
    for (int row = gw; row < M; row += NGW) {
        const float rstd = rsqrtf(rsq[row] * (1.0f / D) + EPS); float* xr = C.out + (size_t)row * D;
#pragma unroll
        for (int j = 0; j < 4; ++j) { const int col = j * 256 + lane * 4; const f32x4 v = *(const f32x4*)(xr + col), gg = *(const f32x4*)(g + col); *(f32x4*)(xr + col) = v * rstd * gg; }
    }
}


#define XB_TMO      128
#define XB_XCNT(j)  (256  + 64 * (j))
#define XB_XSUB(j)  (1280 + 64 * (j))
#define XB_XGEN(j)  (2304 + 64 * (j))
#define XB_TOP      3328
#define XB_TOPGEN   3392
#define XCD_BAR_WORDS 3456
#define XB_SPIN_CAP (1u << 20)
__device__ __forceinline__ unsigned xb_ld(unsigned* p)              { return __hip_atomic_load(p, __ATOMIC_RELAXED, __HIP_MEMORY_SCOPE_AGENT); }
__device__ __forceinline__ unsigned xb_add(unsigned* p, unsigned v) { return __hip_atomic_fetch_add(p, v, __ATOMIC_RELAXED, __HIP_MEMORY_SCOPE_AGENT); }
__device__ __forceinline__ unsigned xb_xcc_id() { return (unsigned)__builtin_amdgcn_s_getreg((3 << 11) | 20) & 0xFu; }
#define XB_SPIN(cond, bar) do { unsigned _sp = 0; while (cond) { __builtin_amdgcn_s_sleep(1); \
    if ((++_sp & 255u) == 0u) { if (xb_ld(&(bar)[XB_TMO])) break; if (_sp > XB_SPIN_CAP) { atomicAdd(&(bar)[XB_TMO], 1u); break; } } } } while (0)
struct XcdBarrier { unsigned* bar; unsigned x; volatile LAS unsigned* st; };
__device__ __forceinline__ XcdBarrier xcd_barrier_post(unsigned* bar, volatile LAS unsigned* st) {
    XcdBarrier b; b.bar = bar; b.x = xb_xcc_id(); b.st = st;
    if (threadIdx.x == 0) (void)xb_add(&bar[XB_XCNT(b.x)], 1u);
    return b;
}
__device__ __forceinline__ void xcd_barrier_complete(unsigned* bar, unsigned x, unsigned& nloc, unsigned& nx) {
    const unsigned G = gridDim.x * gridDim.y * gridDim.z;
    unsigned sum, cnt, mine, sp = 0u;
    for (;;) {
        sum = 0u; cnt = 0u; mine = 0u;
#pragma unroll
        for (unsigned j = 0; j < 16; ++j) { const unsigned c = xb_ld(&bar[XB_XCNT(j)]); sum += c; cnt += (c > 0u) ? 1u : 0u; mine = (j == x) ? c : mine; }
        if (sum == G) break;
        __builtin_amdgcn_s_sleep(1);
        if ((++sp & 255u) == 0u) { if (xb_ld(&bar[XB_TMO])) break; if (sp > XB_SPIN_CAP) { atomicAdd(&bar[XB_TMO], 1u); break; } }
    }
    nloc = mine > 0u ? mine : 1u; nx = cnt > 0u ? cnt : 1u;
}
__device__ __forceinline__ void xcd_barrier(const XcdBarrier& b) {
    asm volatile("s_waitcnt vmcnt(0)" ::: "memory");
    __syncthreads();
    if (threadIdx.x == 0) {
        unsigned* bar = b.bar;
        __builtin_amdgcn_s_waitcnt(0);
        unsigned nloc = b.st[0], nx = b.st[1];
        if (nloc == 0u) { xcd_barrier_complete(bar, b.x, nloc, nx); b.st[0] = nloc; b.st[1] = nx; }
        const unsigned old = xb_add(&bar[XB_XSUB(b.x)], 1u);
        const unsigned gen = old / nloc;
        if (old + 1u == (gen + 1u) * nloc) {
            __builtin_amdgcn_fence(__ATOMIC_RELEASE, "agent");
            asm volatile("s_waitcnt vmcnt(0)" ::: "memory");
            const unsigned og = xb_add(&bar[XB_TOP], 1u);
            const unsigned tg = og / nx;
            if (og + 1u == (tg + 1u) * nx) xb_add(&bar[XB_TOPGEN], 1u);
            else XB_SPIN(xb_ld(&bar[XB_TOPGEN]) == tg, bar);
            __builtin_amdgcn_fence(__ATOMIC_ACQUIRE, "agent");
            xb_add(&bar[XB_XGEN(b.x)], 1u);
            asm volatile("s_waitcnt vmcnt(0)" ::: "memory");
        } else {
            XB_SPIN(xb_ld(&bar[XB_XGEN(b.x)]) == gen, bar);
            __builtin_amdgcn_fence(__ATOMIC_ACQUIRE, "agent");
            asm volatile("s_waitcnt vmcnt(0)" ::: "memory");
        }
    }
    __syncthreads();
}

__global__ void __launch_bounds__(NTHREADS, 2) fwd_kernel(Args args) {
    extern __shared__ __attribute__((aligned(16))) unsigned char lds_raw[];
    Ctx C;
    C.lds = (LAS unsigned char*)lds_raw;
    C.tid = threadIdx.x; C.lane = C.tid & 63; C.wave = __builtin_amdgcn_readfirstlane(C.tid >> 6);
    C.G = gridDim.x; { const int bx = blockIdx.x; C.vcu = (C.G % 8 == 0) ? (bx % 8) * (C.G / 8) + bx / 8 : bx; }
    C.in = args.in; C.out = args.out; C.ws = args.ws;
    C.ctlf = (float*)(args.ws + WS_CTL); C.vec = (float*)(args.ws + WS_VEC);
    unsigned char* ws = args.ws;
    const int lo = args.ph_lo, hi = args.ph_hi;
    float* mod = C.ctlf + CW_MOD;
    h16* AX = (h16*)(ws + WS_AX); h16* AY = (h16*)(ws + WS_AY); h16* HID = (h16*)(ws + WS_HID);
    volatile LAS unsigned* MISC = (volatile LAS unsigned*)(C.lds + MISC_OFF);
    if (C.tid < 32) MISC[C.tid] = 0u;
    __syncthreads();
    XcdBarrier bar = xcd_barrier_post((unsigned*)C.ctlf + CW_BAR, MISC + 8);
#define IN(k) (lo <= (k) && (k) < hi)
#define SEAM(k) do { if (IN(k) && IN((k) + 1)) xcd_barrier(bar); } while (0)
    if (IN(0)) { phase0(C); SEAM(0); }
    if (IN(1)) { phase1(C); SEAM(1); }
    if (IN(2)) { EpiWin E{(h16*)(ws + WS_Q), (h16*)C.out, (h16*)C.out + (size_t)M * D, (bf16_t*)(ws + WS_V), (h16*)(ws + WS_G)};
        naive_gemm_phase(C, AX, (const h16*)(ws + WS_W_HIN), M, N_HIN, D, E); SEAM(2); }
    if (IN(3)) { naive_scan_phase(C); SEAM(3); }
    if (IN(4)) { naive_combine_phase(C); SEAM(4); }
    if (IN(5)) { EpiRes E{C.in[0], C.in[1], C.out, mod + 2 * D, C.vec + VW_GN, AY, C.ctlf + CW_RSQ_A};
        naive_gemm_phase(C, AX, (const h16*)(ws + WS_W_HOUT), M, D, D, E); SEAM(5); }
    if (IN(6)) { EpiHid E{C.ctlf + CW_RSQ_A, C.vec + VW_BMLP, HID};
        naive_gemm_phase(C, AY, (const h16*)(ws + WS_W_W1), M, FF, D, E); SEAM(6); }
    if (IN(7)) { EpiRes E{nullptr, nullptr, C.out, mod + 5 * D, C.vec + VW_GN + NCOND * D, AY, C.ctlf + CW_RSQ_B};
        naive_gemm_phase(C, HID, (const h16*)(ws + WS_W_W2), M, D, FF, E); SEAM(7); }
    if (IN(8)) { EpiCin E{C.ctlf + CW_RSQ_B, C.vec + VW_BCM, (h16*)(ws + WS_U), (h16*)(ws + WS_V2), C.ctlf + CW_VS1, C.ctlf + CW_VS2};
        naive_gemm_phase(C, AY, (const h16*)(ws + WS_W_CIN), M, N_CIN, D, E); SEAM(8); }
    if (IN(9)) { naive_spatial_phase(C); SEAM(9); }
    if (IN(10)) { EpiRes E{nullptr, nullptr, C.out, mod + (size_t)NCOND * 6 * D + 2 * D, C.vec + VW_GN + 2 * NCOND * D, AY, C.ctlf + CW_RSQ_C};
        naive_gemm_phase(C, AX, (const h16*)(ws + WS_W_COUT), M, D, D, E); SEAM(10); }
    if (IN(11)) { EpiHid E{C.ctlf + CW_RSQ_C, C.vec + VW_BMLP + NCOND * FF, HID};
        naive_gemm_phase(C, AY, (const h16*)(ws + WS_W_W1 + 8 * MiB), M, FF, D, E); SEAM(11); }
    if (IN(12)) { EpiRes E{nullptr, nullptr, C.out, mod + (size_t)NCOND * 6 * D + 5 * D, nullptr, nullptr, C.ctlf + CW_RSQ_D};
        naive_gemm_phase(C, HID, (const h16*)(ws + WS_W_W2 + 8 * MiB), M, D, FF, E); SEAM(12); }
    if (IN(13)) { final_norm_phase(C); }
#undef IN
#undef SEAM
}


extern "C" void kernel_launch(void* const* d_in, const int* in_sizes, int n_in, void* d_out, int out_size, void* d_ws, size_t ws_size, hipStream_t stream) {
    static int grid = 0;
    if (grid == 0) {
        if (n_in != 22 || ws_size < WS_END) { fprintf(stderr, "kernel_launch: unexpected shapes (n_in %d, ws %zu)\n", n_in, ws_size); grid = -1; return; }
        int dev = 0, cus = 0;
        if (hipGetDevice(&dev) != hipSuccess || hipDeviceGetAttribute(&cus, hipDeviceAttributeMultiprocessorCount, dev) != hipSuccess) { grid = -1; return; }
        if (hipFuncSetAttribute((const void*)fwd_kernel, hipFuncAttributeMaxDynamicSharedMemorySize, LDS_BYTES) != hipSuccess) { fprintf(stderr, "kernel_launch: hipFuncSetAttribute failed\n"); grid = -1; return; }
        grid = cus;
    }
    if (grid < 0) return;
    (void)hipMemsetAsync((char*)d_ws + WS_CTL, 0, CTL_ZERO_BYTES, stream);
    Args a{};
    for (int i = 0; i < 22; ++i) a.in[i] = (const float*)d_in[i];
    a.out = (float*)d_out; a.ws = (unsigned char*)d_ws;
#if MK_LAUNCH_PER_PHASE
    for (int p = 0; p < NPHASES; ++p) { a.ph_lo = p; a.ph_hi = p + 1; hipLaunchKernelGGL(fwd_kernel, dim3(grid), dim3(NTHREADS), LDS_BYTES, stream, a); }
#else
    a.ph_lo = 0; a.ph_hi = NPHASES; hipLaunchKernelGGL(fwd_kernel, dim3(grid), dim3(NTHREADS), LDS_BYTES, stream, a);
#endif
}
```

```cpp
#include <hip/hip_runtime.h>
#include <cstdio>
#include <cstdint>

#ifndef MK_FAST_GEMM
#define MK_FAST_GEMM 1
#endif
#ifndef MK_LAUNCH_PER_PHASE
#define MK_LAUNCH_PER_PHASE 0
#endif

#define GAS __attribute__((address_space(1)))
#define LAS __attribute__((address_space(3)))
typedef _Float16 h16;
typedef _Float16 h16x2 __attribute__((ext_vector_type(2)));
typedef _Float16 h16x4 __attribute__((ext_vector_type(4)));
typedef _Float16 h16x8 __attribute__((ext_vector_type(8)));
typedef float f32x2 __attribute__((ext_vector_type(2)));
typedef float f32x4 __attribute__((ext_vector_type(4)));
typedef unsigned u32x2 __attribute__((ext_vector_type(2)));
typedef unsigned u32x4 __attribute__((ext_vector_type(4)));
typedef unsigned short bf16_t;
typedef __bf16 bf16x2_t __attribute__((ext_vector_type(2)));

constexpr int D = 1024, M_CTX = 4096, M_LAT = 16384, M = M_CTX + M_LAT, FF = 4096, NCOND = 5, NH = 8, HD = 128;
constexpr int N_HIN = 5 * D, N_CIN = 2 * D;
constexpr float EPS = 1e-6f;
constexpr int NWAVES = 8, NTHREADS = 512, NPHASES = 14;
constexpr int LDS_BYTES = 147456, MISC_OFF = 131072 + 320;

constexpr size_t MiB = 1u << 20;
constexpr size_t WS_CTL = 0, CTL_ZERO_BYTES = 1 * MiB;
constexpr int CW_TMO = 0, CW_BAR = 1024, CW_MOD = 8192, CW_RSQ_A = CW_MOD + 2 * NCOND * 6 * D, CW_RSQ_B = CW_RSQ_A + M, CW_RSQ_C = CW_RSQ_B + M,
              CW_RSQ_D = CW_RSQ_C + M, CW_VS1 = CW_RSQ_D + M, CW_VS2 = CW_VS1 + M, CW_END = CW_VS2 + M;
static_assert((size_t)CW_END * 4 <= CTL_ZERO_BYTES, "ctl words");
constexpr size_t WS_VEC = 1 * MiB;
constexpr int VW_GN = 0  , VW_BMLP = VW_GN + 3 * NCOND * D  , VW_BCM = VW_BMLP + 2 * NCOND * FF  , VW_LB = VW_BCM + NCOND * N_CIN  , VW_END = VW_LB + 2 * D;
static_assert((size_t)VW_END * 4 <= MiB, "vec words");
constexpr size_t WS_W_HIN = 2 * MiB, WS_W_HOUT = 12 * MiB, WS_W_CIN = 14 * MiB, WS_W_COUT = 18 * MiB, WS_W_W1 = 20 * MiB  , WS_W_W2 = 36 * MiB  , WS_W_WS = 52 * MiB;
constexpr size_t WS_AY = 54 * MiB, WS_AX = 94 * MiB, WS_Q = 134 * MiB, WS_V = 174 * MiB, WS_G = 214 * MiB, WS_END = 254 * MiB;
constexpr size_t WS_HID = WS_AX;
constexpr size_t WS_U = WS_Q, WS_V2 = WS_V;
constexpr size_t ACT_BYTES = (size_t)M * D * 2;
static_assert(ACT_BYTES == 40 * MiB && WS_HID + (size_t)M * FF * 2 == WS_END, "map");

__device__ __forceinline__ float ex2(float x) { return __builtin_amdgcn_exp2f(x); }
__device__ __forceinline__ float rcpf(float x) { return __builtin_amdgcn_rcpf(x); }
__device__ __forceinline__ float sigmoidf_(float x) { return rcpf(1.0f + ex2(-1.4426950408889634f * x)); }
__device__ __forceinline__ float siluf_(float x) { return x * sigmoidf_(x); }
__device__ __forceinline__ float gelu_tanh(float x) { const float y = 0.7978845608028654f * (x + 0.044715f * x * x * x); const float t = 1.0f - 2.0f * rcpf(1.0f + ex2(2.885390081777927f * y)); return 0.5f * x * (1.0f + t); }
__device__ __forceinline__ float bf2f(bf16_t b) { return __uint_as_float((unsigned)b << 16); }
__device__ __forceinline__ unsigned pk_bf16(float lo, float hi) { f32x2 v = {lo, hi}; bf16x2_t b = __builtin_convertvector(v, bf16x2_t); return __builtin_bit_cast(unsigned, b); }
__device__ __forceinline__ unsigned pk_h16(float lo, float hi) { f32x2 v = {lo, hi}; h16x2 b = __builtin_convertvector(v, h16x2); return __builtin_bit_cast(unsigned, b); }
__device__ __forceinline__ void st_h16x4(h16* p, f32x4 v) { u32x2 w; w.x = pk_h16(v.x, v.y); w.y = pk_h16(v.z, v.w); *(u32x2*)p = w; }
__device__ __forceinline__ void st_bf16x4(bf16_t* p, f32x4 v) { u32x2 w; w.x = pk_bf16(v.x, v.y); w.y = pk_bf16(v.z, v.w); *(u32x2*)p = w; }
__device__ __forceinline__ float wave_sum(float v) {
#pragma unroll
    for (int o = 1; o < 64; o <<= 1) v += __shfl_xor(v, o);
    return v;
}
__device__ __forceinline__ int cond_of_row(int row) { return row < M_CTX ? 0 : 1 + ((row - M_CTX) >> 12); }

struct Args { const float* in[22]; float* out; unsigned char* ws; int ph_lo, ph_hi; };

struct Ctx {
    LAS unsigned char* lds;
    int tid, lane, wave, vcu, G;
    const float* const* in; float* out; unsigned char* ws;
    float* ctlf; float* vec;
};

struct EpiWin {
    static constexpr bool STATS = false;
    h16* Q; h16* ZF; h16* ZB; bf16_t* V; h16* Gt;
    __device__ __forceinline__ void apply(int row, int col, f32x4 a, float&, float&) const {
        const int grp = col >> 10, cc = col & 1023; const size_t off = (size_t)row * D + cc;
        if (grp == 0) { f32x4 s = {siluf_(a.x), siluf_(a.y), siluf_(a.z), siluf_(a.w)}; st_h16x4(Q + off, s); }
        else if (grp == 1) st_h16x4(ZF + off, a);
        else if (grp == 2) st_h16x4(ZB + off, a);
        else if (grp == 3) st_bf16x4(V + off, a);
        else { f32x4 s = {siluf_(a.x), siluf_(a.y), siluf_(a.z), siluf_(a.w)}; st_h16x4(Gt + off, s); }
    }
    __device__ __forceinline__ void commit(int, int, float, float) const {}
};
struct EpiRes {
    static constexpr bool STATS = true;
    const float* xp; const float* xs;
    float* out; const float* gate;
    const float* gn; h16* Aout;
    float* rsq;
    __device__ __forceinline__ void apply(int row, int col, f32x4 a, float&, float& s2) const {
        const int cond = cond_of_row(row); const size_t off = (size_t)row * D + col;
        const float* xo = xp ? (row < M_CTX ? xp + off : xs + (off - (size_t)M_CTX * D)) : out + off;
        const f32x4 x0 = *(const f32x4*)xo, g = *(const f32x4*)(gate + cond * 6 * D + col);
        const f32x4 xn = x0 + g * a;
        *(f32x4*)(out + off) = xn;
        s2 += (xn.x * xn.x + xn.y * xn.y) + (xn.z * xn.z + xn.w * xn.w);
        if (Aout) { const f32x4 gv = *(const f32x4*)(gn + cond * D + col); st_h16x4(Aout + off, xn * gv); }
    }
    __device__ __forceinline__ void commit(int row, int, float, float s2) const { atomicAdd(rsq + row, s2); }
};
struct EpiHid {
    static constexpr bool STATS = false;
    const float* rsq; const float* bias; h16* H;
    __device__ __forceinline__ void apply(int row, int col, f32x4 a, float&, float&) const {
        const int cond = cond_of_row(row); const float rstd = rsqrtf(rsq[row] * (1.0f / D) + EPS);
        const f32x4 b = *(const f32x4*)(bias + cond * FF + col);
        f32x4 z = a * rstd + b; z.x = fmaxf(z.x, 0.f); z.y = fmaxf(z.y, 0.f); z.z = fmaxf(z.z, 0.f); z.w = fmaxf(z.w, 0.f);
        st_h16x4(H + (size_t)row * FF + col, z * z);
    }
    __device__ __forceinline__ void commit(int, int, float, float) const {}
};
struct EpiCin {
    static constexpr bool STATS = true;
    const float* rsq; const float* bias; h16* U; h16* V2; float* vs1; float* vs2;
    __device__ __forceinline__ void apply(int row, int col, f32x4 a, float& s1, float& s2) const {
        const int cond = cond_of_row(row); const float rstd = rsqrtf(rsq[row] * (1.0f / D) + EPS);
        const f32x4 b = *(const f32x4*)(bias + cond * N_CIN + col);
        f32x4 z = a * rstd + b; z.x = gelu_tanh(z.x); z.y = gelu_tanh(z.y); z.z = gelu_tanh(z.z); z.w = gelu_tanh(z.w);
        if (col < D) st_h16x4(U + (size_t)row * D + col, z);
        else { st_h16x4(V2 + (size_t)row * D + (col - D), z); s1 += (z.x + z.y) + (z.z + z.w); s2 += (z.x * z.x + z.y * z.y) + (z.z * z.z + z.w * z.w); }
    }
    __device__ __forceinline__ void commit(int row, int col, float s1, float s2) const { if (col >= D) { atomicAdd(vs1 + row, s1); atomicAdd(vs2 + row, s2); } }
};

template <class Epi>
__device__ __forceinline__ void naive_gemm_phase(const Ctx& C, const h16* A, const h16* Wt, int Mr, int N, int K, const Epi& E) {
    LAS float* As = (LAS float*)C.lds; LAS float* Bs = As + 16 * 132;
    const int tid = C.tid, ty = tid >> 5, tx = tid & 31;
    const int ntn = N / 128, ntiles = (Mr / 128) * ntn;
    for (int t = C.vcu; t < ntiles; t += C.G) {
        const int pm = t / ntn, pn = t % ntn;
        f32x4 acc[8];
#pragma unroll
        for (int i = 0; i < 8; ++i) acc[i] = (f32x4){0.f, 0.f, 0.f, 0.f};
        const int r = tid >> 2, kk = (tid & 3) * 4;
        const h16* ap = A + (size_t)(pm * 128 + r) * K + kk; const h16* bp = Wt + (size_t)(pn * 128 + r) * K + kk;
        for (int k0 = 0; k0 < K; k0 += 16) {
            const h16x4 a = *(const h16x4*)(ap + k0), b = *(const h16x4*)(bp + k0);
            __syncthreads();
#pragma unroll
            for (int j = 0; j < 4; ++j) { As[(kk + j) * 132 + r] = (float)a[j]; Bs[(kk + j) * 132 + r] = (float)b[j]; }
            __syncthreads();
#pragma unroll 2
            for (int k = 0; k < 16; ++k) {
                const f32x4 a0 = *(LAS f32x4*)(As + k * 132 + ty * 8), a1 = *(LAS f32x4*)(As + k * 132 + ty * 8 + 4), bv = *(LAS f32x4*)(Bs + k * 132 + tx * 4);
                acc[0] += a0.x * bv; acc[1] += a0.y * bv; acc[2] += a0.z * bv; acc[3] += a0.w * bv;
                acc[4] += a1.x * bv; acc[5] += a1.y * bv; acc[6] += a1.z * bv; acc[7] += a1.w * bv;
            }
        }
#pragma unroll
        for (int i = 0; i < 8; ++i) { float s1 = 0.f, s2 = 0.f; const int row = pm * 128 + ty * 8 + i, col = pn * 128 + tx * 4; E.apply(row, col, acc[i], s1, s2); E.commit(row, col, s1, s2); }
    }
    __syncthreads();
}


namespace pg8 {
constexpr int BM = 256, BK = 64, HALF = 128, HTB = HALF * BK * 2, STAGE_BYTES = 8 * HTB, NXCD = 8, WGM = 8;
__host__ __device__ __forceinline__ int lds_byte(int r, int c) { const int st = (r >> 4) * 2 + (c >> 5), rr = r & 15, cc = c & 31, ob = rr * 64 + cc * 2; return st * 1024 + (ob ^ (((ob >> 9) & 1) << 5)); }
__host__ __device__ __forceinline__ void stage_rc(int b, int& R, int& C) { const int st = b / 1024, sb = b % 1024, swz = sb ^ (((sb >> 9) & 1) << 5); R = (st >> 1) * 16 + swz / 64; C = (st & 1) * 32 + (swz % 64) / 2; }
__host__ __device__ __forceinline__ int perm32(int rho) { const int n = rho >> 4, i = rho & 15; return 8 * (i >> 2) + 4 * n + (i & 3); }
struct Unit { int pm, pn; };
struct StaticOrder {
    int nM, nN, nwg, G, c;
    __host__ __device__ void init(int M_, int N_, int G_, int c_) { nM = M_ / BM; nN = N_ / BM; nwg = nM * nN; G = G_; c = c_; }
    __host__ __device__ bool next(int i, Unit& u) const {
        const long L = (long)i * G + c; if (L >= nwg) return false;
        int wgid = (int)L; { const int q = nwg / NXCD, r = nwg % NXCD, xcd = wgid % NXCD, off = wgid / NXCD; wgid = (xcd < r ? xcd * (q + 1) : r * (q + 1) + (xcd - r) * q) + off; }
        const int nig = WGM * nN, gid = wgid / nig, fm = gid * WGM, gsz = (nM - fm) < WGM ? (nM - fm) : WGM;
        u.pm = fm + ((wgid % nig) % gsz); u.pn = (wgid % nig) / gsz; return true;
    }
};
template <class Epi, bool PERM>
__device__ __forceinline__ void run_epi(const Epi& E, const f32x4 (&acc)[2][2][4][2], const Unit& u, int wr, int wc, int fr, int fq) {
#pragma unroll
    for (int ai = 0; ai < 2; ++ai)
#pragma unroll
        for (int m = 0; m < 4; ++m) {
            const int row = u.pm * BM + ai * HALF + wr * 64 + m * 16 + fr; float s1 = 0.f, s2 = 0.f;
#pragma unroll
            for (int bj = 0; bj < 2; ++bj)
#pragma unroll
                for (int n = 0; n < 2; ++n) { const int col = u.pn * BM + bj * HALF + wc * 32 + (PERM ? 8 * fq + 4 * n : 16 * n + 4 * fq); E.apply(row, col, acc[ai][bj][m][n], s1, s2); }
            if (Epi::STATS) { s1 += __shfl_xor(s1, 16); s1 += __shfl_xor(s1, 32); s2 += __shfl_xor(s2, 16); s2 += __shfl_xor(s2, 32); if (fq == 0) E.commit(row, u.pn * BM, s1, s2); }
        }
}
template <class Epi, bool PERM>
__device__ __forceinline__ void gemm_phase(LAS unsigned char* lds, const h16* Ag, const h16* Btg, int K, const StaticOrder& S, const Epi& E) {
    const int tid = threadIdx.x, wid = __builtin_amdgcn_readfirstlane(tid >> 6), lane = tid & 63, wr = wid >> 2, wc = wid & 3, fr = lane & 15, fq = lane >> 4;
    const int nt = K / BK;
    unsigned voffA[2], voffB[2];
#pragma unroll
    for (int i = 0; i < 2; ++i) { int R, Cc; stage_rc(tid * 16 + i * 8192, R, Cc); const int Rb = PERM ? ((R & ~31) + perm32(R & 31)) : R;
        voffA[i] = (unsigned)(R * K + Cc) * 2u; voffB[i] = (unsigned)(Rb * K + Cc) * 2u; }
    const size_t kstep = (size_t)(BK * 2), hstep = (size_t)HALF * K * 2, tstep = 2 * hstep;
    const unsigned ldsw = (unsigned)wid * 1024u;
    const int aoff = lds_byte(wr * 64 + fr, fq * 8), boff = lds_byte(wc * 32 + fr, fq * 8);
#define PG8_SA(b, h) (((b) * 2 + (h)) * HTB)
#define PG8_SB(b, h) ((4 + (b) * 2 + (h)) * HTB)
#define PG8_STAGE(bufoff, gbase, voff) do { _Pragma("unroll") for (int _i = 0; _i < 2; ++_i) \
        __builtin_amdgcn_global_load_lds((const unsigned*)((const char*)(gbase) + (voff)[_i]), (LAS unsigned*)(lds + (bufoff) + ldsw + _i * 8192), 16, 0, 0); } while (0)
#define PG8_LDA(dst, b, h) do { _Pragma("unroll") for (int m = 0; m < 4; ++m) _Pragma("unroll") for (int k = 0; k < 2; ++k) dst[m][k] = *(const LAS h16x8*)(lds + PG8_SA(b, h) + aoff + m * 2048 + k * 1024); } while (0)
#define PG8_LDB(dst, b, h) do { _Pragma("unroll") for (int n = 0; n < 2; ++n) _Pragma("unroll") for (int k = 0; k < 2; ++k) dst[n][k] = *(const LAS h16x8*)(lds + PG8_SB(b, h) + boff + n * 2048 + k * 1024); } while (0)
#define PG8_MMA(ai, bj, At, Bt) do { __builtin_amdgcn_s_setprio(1); _Pragma("unroll") for (int m = 0; m < 4; ++m) _Pragma("unroll") for (int n = 0; n < 2; ++n) _Pragma("unroll") for (int k = 0; k < 2; ++k) \
        acc[ai][bj][m][n] = __builtin_amdgcn_mfma_f32_16x16x32_f16(Bt[n][k], At[m][k], acc[ai][bj][m][n], 0, 0, 0); __builtin_amdgcn_s_setprio(0); } while (0)
#define PG8_WAIT_V(n) asm volatile("s_waitcnt vmcnt(" #n ")" ::: "memory")
#define PG8_WAIT_L(n) asm volatile("s_waitcnt lgkmcnt(" #n ")" ::: "memory")
#define PG8_BAR __builtin_amdgcn_s_barrier()
#define PG8_SCHED __builtin_amdgcn_sched_barrier(0)
    Unit cur, nxt; int ui = 0;
    if (!S.next(0, cur)) return;
    f32x4 acc[2][2][4][2];
#pragma unroll
    for (int a = 0; a < 2; ++a)
#pragma unroll
        for (int b = 0; b < 2; ++b)
#pragma unroll
            for (int m = 0; m < 4; ++m)
#pragma unroll
                for (int n = 0; n < 2; ++n) acc[a][b][m][n] = (f32x4){0.f, 0.f, 0.f, 0.f};
    h16x8 At[4][2], B0[2][2], B1[2][2];
    const char* cA = (const char*)Ag + (size_t)cur.pm * tstep; const char* cB = (const char*)Btg + (size_t)cur.pn * tstep;
    PG8_STAGE(PG8_SB(0, 0), cB, voffB); PG8_STAGE(PG8_SB(0, 1), cB + hstep, voffB); PG8_STAGE(PG8_SA(0, 0), cA, voffA); PG8_STAGE(PG8_SA(0, 1), cA + hstep, voffA);
    if (wr == 1) PG8_BAR;
    PG8_WAIT_V(2); PG8_BAR;
    PG8_STAGE(PG8_SB(1, 0), cB + kstep, voffB); PG8_STAGE(PG8_SA(1, 0), cA + kstep, voffA); PG8_STAGE(PG8_SB(1, 1), cB + hstep + kstep, voffB);
    PG8_WAIT_V(6); PG8_BAR;
    for (;;) {
        const bool has_next = S.next(ui + 1, nxt);
        const char* nA = has_next ? (const char*)Ag + (size_t)nxt.pm * tstep : cA; const char* nB = has_next ? (const char*)Btg + (size_t)nxt.pn * tstep : cB;
        for (int t = 0; t < nt; t += 2) {
            const bool last = (t == nt - 2);
            const char* a1 = cA + (size_t)(t + 1) * kstep;
            const char* a2 = last ? nA : cA + (size_t)(t + 2) * kstep; const char* b2 = last ? nB : cB + (size_t)(t + 2) * kstep;
            const char* a3 = a2 + kstep; const char* b3 = b2 + kstep;
            PG8_LDB(B0, 0, 0); PG8_LDB(B1, 0, 1); PG8_SCHED; PG8_LDA(At, 0, 0); PG8_STAGE(PG8_SA(1, 1), a1 + hstep, voffA);
            PG8_WAIT_V(8); PG8_WAIT_L(0); PG8_BAR; PG8_MMA(0, 0, At, B0); PG8_MMA(0, 1, At, B1); PG8_BAR; PG8_SCHED;
            PG8_LDA(At, 0, 1); PG8_STAGE(PG8_SB(0, 0), b2, voffB); PG8_STAGE(PG8_SB(0, 1), b2 + hstep, voffB); PG8_STAGE(PG8_SA(0, 0), a2, voffA);
            PG8_WAIT_V(8); PG8_WAIT_L(0); PG8_BAR; PG8_MMA(1, 0, At, B0); PG8_MMA(1, 1, At, B1); PG8_BAR; PG8_SCHED;
            PG8_LDB(B0, 1, 0); PG8_LDB(B1, 1, 1); PG8_SCHED; PG8_LDA(At, 1, 0); PG8_STAGE(PG8_SA(0, 1), a2 + hstep, voffA);
            PG8_WAIT_V(8); PG8_WAIT_L(0); PG8_BAR; PG8_MMA(0, 0, At, B0); PG8_MMA(0, 1, At, B1); PG8_BAR; PG8_SCHED;
            PG8_LDA(At, 1, 1); PG8_STAGE(PG8_SB(1, 0), b3, voffB); PG8_STAGE(PG8_SB(1, 1), b3 + hstep, voffB); PG8_STAGE(PG8_SA(1, 0), a3, voffA);
            PG8_WAIT_V(8); PG8_WAIT_L(0); PG8_BAR; PG8_MMA(1, 0, At, B0); PG8_MMA(1, 1, At, B1); PG8_BAR; PG8_SCHED;
        }
        if (wr == 0) PG8_BAR;
        run_epi<Epi, PERM>(E, acc, cur, wr, wc, fr, fq);
        if (!has_next) break;
#pragma unroll
        for (int a = 0; a < 2; ++a)
#pragma unroll
            for (int b = 0; b < 2; ++b)
#pragma unroll
                for (int m = 0; m < 4; ++m)
#pragma unroll
                    for (int n = 0; n < 2; ++n) acc[a][b][m][n] = (f32x4){0.f, 0.f, 0.f, 0.f};
        cur = nxt; cA = nA; cB = nB; ++ui;
        if (wr == 1) PG8_BAR;
    }
    PG8_WAIT_V(0);
    PG8_BAR;
#undef PG8_SA
#undef PG8_SB
#undef PG8_STAGE
#undef PG8_LDA
#undef PG8_LDB
#undef PG8_MMA
#undef PG8_WAIT_V
#undef PG8_WAIT_L
#undef PG8_BAR
#undef PG8_SCHED
}
}
template <class Epi, bool PERM>
__device__ __forceinline__ void fast_gemm_phase(const Ctx& C, const h16* A, const h16* Wt, int Mr, int N, int K, const Epi& E) {
    pg8::StaticOrder S; S.init(Mr, N, C.G, (int)blockIdx.x);
    pg8::gemm_phase<Epi, PERM>(C.lds, A, Wt, K, S, E);
    __syncthreads();
}

__device__ __forceinline__ void p0_transpose_item(const float* W, int K, int N, h16* WT, LAS float* scr, int item, int lane) {
    const int nblk = N / 32, kb = item / nblk, nb = item % nblk, k0 = 64 * kb, n0 = 32 * nb;
#pragma unroll 8
    for (int i = 0; i < 32; ++i) { const int kk = 2 * i + (lane >> 5); scr[kk * 33 + (lane & 31)] = W[(size_t)(k0 + kk) * N + n0 + (lane & 31)]; }
    asm volatile("s_waitcnt lgkmcnt(0)" ::: "memory");
    const int c = lane & 7;
#pragma unroll
    for (int j = 0; j < 4; ++j) { const int n = (lane >> 3) + 8 * j; const LAS float* s = scr + (8 * c) * 33 + n;
        u32x4 o; o.x = pk_h16(s[0 * 33], s[1 * 33]); o.y = pk_h16(s[2 * 33], s[3 * 33]); o.z = pk_h16(s[4 * 33], s[5 * 33]); o.w = pk_h16(s[6 * 33], s[7 * 33]);
        *(u32x4*)(WT + (size_t)(n0 + n) * K + k0 + 8 * c) = o; }
    asm volatile("s_waitcnt lgkmcnt(0)" ::: "memory");
}
__device__ __forceinline__ void phase0(const Ctx& C) {
    LAS float* scr = (LAS float*)(C.lds + C.wave * 16384);
    const int gw = C.vcu * NWAVES + C.wave, NGW = C.G * NWAVES;
    unsigned char* ws = C.ws;
    constexpr int I_HIN = (D / 64) * (N_HIN / 32), I_DD = (D / 64) * (D / 32), I_CIN = (D / 64) * (N_CIN / 32), I_W1 = (D / 64) * (FF / 32), I_W2 = (FF / 64) * (D / 32);
    constexpr int NITEMS = I_HIN + 2 * I_DD + I_CIN + 2 * I_W1 + 2 * I_W2;
    for (int it = gw; it < NITEMS; it += NGW) {
        int r = it;
        if (r < I_HIN) { p0_transpose_item(C.in[11], D, N_HIN, (h16*)(ws + WS_W_HIN), scr, r, C.lane); continue; } r -= I_HIN;
        if (r < I_DD) { p0_transpose_item(C.in[14], D, D, (h16*)(ws + WS_W_HOUT), scr, r, C.lane); continue; } r -= I_DD;
        if (r < I_CIN) { p0_transpose_item(C.in[15], D, N_CIN, (h16*)(ws + WS_W_CIN), scr, r, C.lane); continue; } r -= I_CIN;
        if (r < I_DD) { p0_transpose_item(C.in[20], D, D, (h16*)(ws + WS_W_COUT), scr, r, C.lane); continue; } r -= I_DD;
        if (r < 2 * I_W1) { const int l = r / I_W1; p0_transpose_item(C.in[9] + (size_t)l * D * FF, D, FF, (h16*)(ws + WS_W_W1 + (size_t)l * 8 * MiB), scr, r % I_W1, C.lane); continue; } r -= 2 * I_W1;
        { const int l = r / I_W2; p0_transpose_item(C.in[10] + (size_t)l * FF * D, FF, D, (h16*)(ws + WS_W_W2 + (size_t)l * 8 * MiB), scr, r % I_W2, C.lane); }
    }
    { const float* src = C.in[18]; h16* dst = (h16*)(ws + WS_W_WS);
      for (int i = (gw * 64 + C.lane) * 4; i < 8 * 128 * 128; i += NGW * 64 * 4) st_h16x4(dst + i, *(const f32x4*)(src + i)); }
    float* mod = C.ctlf + CW_MOD;
    for (int task = gw; task < 2 * 32 * 24; task += NGW) {
        const int l = task / (32 * 24), rem = task % (32 * 24), kc = rem / 24, cb = rem % 24;
        const int col = cb * 256 + C.lane * 4, k0 = kc * 32;
        const float* W = C.in[5] + (size_t)l * D * 6 * D;
        f32x4 acc[NCOND];
#pragma unroll
        for (int c = 0; c < NCOND; ++c) acc[c] = (f32x4){0.f, 0.f, 0.f, 0.f};
        for (int kk = 0; kk < 32; ++kk) {
            const f32x4 w = *(const f32x4*)(W + (size_t)(k0 + kk) * 6 * D + col);
#pragma unroll
            for (int c = 0; c < NCOND; ++c) { const float cv = (c == 0) ? C.in[4][k0 + kk] : C.in[3][(c - 1) * D + k0 + kk]; acc[c] += siluf_(cv) * w; }
        }
        if (kc == 0) { const f32x4 b = *(const f32x4*)(C.in[6] + (size_t)l * 6 * D + col);
#pragma unroll
            for (int c = 0; c < NCOND; ++c) acc[c] += b; }
#pragma unroll
        for (int c = 0; c < NCOND; ++c) { float* p = mod + ((size_t)l * NCOND + c) * 6 * D + col; atomicAdd(p, acc[c].x); atomicAdd(p + 1, acc[c].y); atomicAdd(p + 2, acc[c].z); atomicAdd(p + 3, acc[c].w); }
    }
}

__device__ __forceinline__ void phase1(const Ctx& C) {
    const int gw = C.vcu * NWAVES + C.wave, NGW = C.G * NWAVES, lane = C.lane;
    const float* mod = C.ctlf + CW_MOD; float* vec = C.vec; unsigned char* ws = C.ws;
    h16* AX = (h16*)(ws + WS_AX);
    const float* g0 = C.in[7];
    for (int row = gw; row < M; row += NGW) {
        const float* xr = row < M_CTX ? C.in[0] + (size_t)row * D : C.in[1] + (size_t)(row - M_CTX) * D;
        const float* mc = mod + (size_t)cond_of_row(row) * 6 * D;
        f32x4 v[4]; float s = 0.f;
#pragma unroll
        for (int j = 0; j < 4; ++j) { v[j] = *(const f32x4*)(xr + j * 256 + lane * 4); s += (v[j].x * v[j].x + v[j].y * v[j].y) + (v[j].z * v[j].z + v[j].w * v[j].w); }
        const float rstd = rsqrtf(wave_sum(s) * (1.0f / D) + EPS);
#pragma unroll
        for (int j = 0; j < 4; ++j) { const int col = j * 256 + lane * 4;
            const f32x4 g = *(const f32x4*)(g0 + col), sh = *(const f32x4*)(mc + col), sc = *(const f32x4*)(mc + D + col);
            st_h16x4(AX + (size_t)row * D + col, v[j] * rstd * g * (sc + 1.0f) + sh); }
    }
    for (int i = gw * 64 + lane; i < 3 * NCOND * D; i += NGW * 64) {
        const int vI = i / (NCOND * D), c = (i / D) % NCOND, col = i % D;
        const float g = vI == 0 ? C.in[8][col] : (vI == 1 ? C.in[7][D + col] : C.in[8][D + col]);
        const int l = vI == 0 ? 0 : 1, slot = vI == 1 ? 1 : 4;
        vec[VW_GN + i] = g * (1.0f + mod[((size_t)l * NCOND + c) * 6 * D + slot * D + col]);
    }
    for (int i = gw * 64 + lane; i < 2 * D; i += NGW * 64) { const float l0 = C.in[12][i], l1 = C.in[12][2 * D + i]; vec[VW_LB + i] = 1.0f / (1.0f + __expf(l1 - l0)); }
    constexpr int NB = 2 * FF + N_CIN;
    for (int task = gw; task < NB; task += NGW) {
        const h16* wrow; const float* sh; float* dst; int stride;
        if (task < FF) { wrow = (const h16*)(ws + WS_W_W1) + (size_t)task * D; sh = mod + 3 * D; dst = vec + VW_BMLP + task; stride = FF; }
        else if (task < 2 * FF) { const int n = task - FF; wrow = (const h16*)(ws + WS_W_W1 + 8 * MiB) + (size_t)n * D; sh = mod + (size_t)NCOND * 6 * D + 3 * D; dst = vec + VW_BMLP + NCOND * FF + n; stride = FF; }
        else { const int n = task - 2 * FF; wrow = (const h16*)(ws + WS_W_CIN) + (size_t)n * D; sh = mod + (size_t)NCOND * 6 * D; dst = vec + VW_BCM + n; stride = N_CIN; }
        float w[16];
        { const h16x8 a = *(const h16x8*)(wrow + lane * 8), b = *(const h16x8*)(wrow + 512 + lane * 8);
#pragma unroll
          for (int j = 0; j < 8; ++j) { w[j] = (float)a[j]; w[8 + j] = (float)b[j]; } }
#pragma unroll
        for (int c = 0; c < NCOND; ++c) { const float* s = sh + (size_t)c * 6 * D; float p = 0.f;
#pragma unroll
            for (int j = 0; j < 8; ++j) { p += w[j] * s[lane * 8 + j]; p += w[8 + j] * s[512 + lane * 8 + j]; }
            p = wave_sum(p); if (lane == 0) dst[(size_t)c * stride] = p; }
    }
}

__device__ __forceinline__ void naive_scan_phase(const Ctx& C) {
    LAS float* sf = (LAS float*)C.lds; LAS float* sk = sf + 8 * 128; LAS float* sq = sk + 8 * 128; LAS float* sv = sq + 8 * 128; LAS float* red = sv + 8 * 128;
    unsigned char* ws = C.ws; const int tid = C.tid;
    const h16* Q = (const h16*)(ws + WS_Q); const bf16_t* V = (const bf16_t*)(ws + WS_V);
    const h16* ZF = (const h16*)C.out; const h16* ZB = ZF + (size_t)M * D;
    const float* lbv = C.vec + VW_LB;
    const int kq = tid >> 7, vv = tid & 127;
    for (int item = C.vcu; item < 320; item += C.G) {
        int seq, h, dir;
        if (item < 64) { seq = 16 + item / 16; h = (item % 16) >> 1; dir = item & 1; } else { const int i2 = item - 64; seq = i2 / 16; h = (i2 % 16) >> 1; dir = i2 & 1; }
        const int L = seq < 16 ? 256 : 4096, row0 = seq < 16 ? seq * 256 : M_CTX + (seq - 16) * 4096;
        const h16* Z = dir ? ZB : ZF; h16* O = (h16*)(ws + (dir ? WS_AY : WS_AX));
        float S[32];
        if (seq < 16) {
#pragma unroll
            for (int i = 0; i < 32; ++i) S[i] = 0.f;
        } else { const float* s0 = C.in[2] + ((((size_t)(seq - 16) * 2 + dir) * NH + h) * HD) * HD;
#pragma unroll
            for (int i = 0; i < 32; ++i) S[i] = s0[(size_t)(kq * 32 + i) * HD + vv]; }
        for (int tb = 0; tb < L; tb += 8) {
            __syncthreads();
            if (tid < 128) { const float lb = lbv[dir * D + h * HD + tid];
#pragma unroll
                for (int j = 0; j < 8; ++j) { const int t = dir ? L - 1 - (tb + j) : tb + j; const size_t off = (size_t)(row0 + t) * D + h * HD + tid;
                    const float f = lb + (1.0f - lb) * sigmoidf_((float)Z[off]); sf[j * 128 + tid] = f; sk[j * 128 + tid] = 1.0f - f; sq[j * 128 + tid] = (float)Q[off]; }
            } else if (tid < 256) { const int c = tid - 128;
#pragma unroll
                for (int j = 0; j < 8; ++j) { const int t = dir ? L - 1 - (tb + j) : tb + j; sv[j * 128 + c] = bf2f(V[(size_t)(row0 + t) * D + h * HD + c]); }
            }
            __syncthreads();
#pragma unroll 1
            for (int j = 0; j < 8; ++j) { const float vval = sv[j * 128 + vv]; float part = 0.f;
#pragma unroll
                for (int i = 0; i < 32; ++i) { const int k = kq * 32 + i; S[i] = sf[j * 128 + k] * S[i] + sk[j * 128 + k] * vval; part += sq[j * 128 + k] * S[i]; }
                red[(kq * 8 + j) * 128 + vv] = part; }
            __syncthreads();
            if (tid < 128) {
#pragma unroll
                for (int j = 0; j < 8; ++j) { const int t = dir ? L - 1 - (tb + j) : tb + j;
                    const float o = (red[(0 * 8 + j) * 128 + tid] + red[(1 * 8 + j) * 128 + tid]) + (red[(2 * 8 + j) * 128 + tid] + red[(3 * 8 + j) * 128 + tid]);
                    O[(size_t)(row0 + t) * D + h * HD + tid] = (h16)o; }
            }
        }
        if (seq < 16) { float* so = C.out + (size_t)M * D + ((((size_t)seq * 2 + dir) * NH + h) * HD) * HD;
#pragma unroll
            for (int i = 0; i < 32; ++i) so[(size_t)(kq * 32 + i) * HD + vv] = S[i]; }
    }
    __syncthreads();
}
__device__ __forceinline__ void naive_combine_phase(const Ctx& C) {
    unsigned char* ws = C.ws; const int gw = C.vcu * NWAVES + C.wave, NGW = C.G * NWAVES, lane = C.lane;
    h16* AX = (h16*)(ws + WS_AX); const h16* AY = (const h16*)(ws + WS_AY); const h16* Gt = (const h16*)(ws + WS_G); const float* og = C.in[13];
    for (int task = gw; task < M * NH; task += NGW) {
        const int row = task >> 3, h = task & 7; const size_t off = (size_t)row * D + h * HD + lane * 2;
        const h16x2 a = *(const h16x2*)(AX + off), b = *(const h16x2*)(AY + off), g = *(const h16x2*)(Gt + off);
        const float o0 = (float)a.x + (float)b.x, o1 = (float)a.y + (float)b.y;
        const float r = rsqrtf(wave_sum(o0 * o0 + o1 * o1) * (1.0f / HD) + EPS);
        *(unsigned*)(AX + off) = pk_h16(o0 * r * og[h * HD + lane * 2] * (float)g.x, o1 * r * og[h * HD + lane * 2 + 1] * (float)g.y);
    }
}

__device__ __forceinline__ void naive_spatial_phase(const Ctx& C) {
    LAS float* As = (LAS float*)C.lds; LAS float* Bs = As + 16 * 132;
    unsigned char* ws = C.ws; const int tid = C.tid, ty = tid >> 5, tx = tid & 31;
    const h16* U = (const h16*)(ws + WS_U); const h16* V2 = (const h16*)(ws + WS_V2); const h16* Wsp = (const h16*)(ws + WS_W_WS); h16* AX = (h16*)(ws + WS_AX);
    const float* vs1 = C.ctlf + CW_VS1; const float* vs2 = C.ctlf + CW_VS2; const float* lng = C.in[16]; const float* lnb = C.in[17]; const float* bs = C.in[19];
    for (int item = C.vcu; item < (M / 128) * 8; item += C.G) {
        const int ch = item >> 3, g = item & 7, r0 = ch * 128;
        f32x4 acc[8];
#pragma unroll
        for (int i = 0; i < 8; ++i) acc[i] = (f32x4){0.f, 0.f, 0.f, 0.f};
        const int r = tid >> 2, kk = (tid & 3) * 4;
        for (int k0 = 0; k0 < 128; k0 += 16) {
            const h16x4 a = *(const h16x4*)(Wsp + ((size_t)g * 128 + r) * 128 + k0 + kk);
            const int qq = tid >> 5, c4 = (tid & 31) * 4, qrow = r0 + k0 + qq;
            const h16x4 vr = *(const h16x4*)(V2 + (size_t)qrow * D + g * 128 + c4);
            const float mu = vs1[qrow] * (1.0f / D), var = vs2[qrow] * (1.0f / D) - mu * mu, rs = rsqrtf(var + EPS);
            const f32x4 lg = *(const f32x4*)(lng + g * 128 + c4), lb = *(const f32x4*)(lnb + g * 128 + c4);
            f32x4 vn; vn.x = ((float)vr.x - mu) * rs * lg.x + lb.x; vn.y = ((float)vr.y - mu) * rs * lg.y + lb.y; vn.z = ((float)vr.z - mu) * rs * lg.z + lb.z; vn.w = ((float)vr.w - mu) * rs * lg.w + lb.w;
            __syncthreads();
#pragma unroll
            for (int j = 0; j < 4; ++j) As[(kk + j) * 132 + r] = (float)a[j];
            *(LAS f32x4*)(Bs + qq * 132 + c4) = vn;
            __syncthreads();
#pragma unroll 2
            for (int k = 0; k < 16; ++k) {
                const f32x4 a0 = *(LAS f32x4*)(As + k * 132 + ty * 8), a1 = *(LAS f32x4*)(As + k * 132 + ty * 8 + 4), bv = *(LAS f32x4*)(Bs + k * 132 + tx * 4);
                acc[0] += a0.x * bv; acc[1] += a0.y * bv; acc[2] += a0.z * bv; acc[3] += a0.w * bv;
                acc[4] += a1.x * bv; acc[5] += a1.y * bv; acc[6] += a1.z * bv; acc[7] += a1.w * bv;
            }
        }
#pragma unroll
        for (int i = 0; i < 8; ++i) { const int p = ty * 8 + i; const size_t off = (size_t)(r0 + p) * D + g * 128 + tx * 4;
            const h16x4 u = *(const h16x4*)(U + off); const float b = bs[g * 128 + p];
            f32x4 o; o.x = (float)u.x * (acc[i].x + b); o.y = (float)u.y * (acc[i].y + b); o.z = (float)u.z * (acc[i].z + b); o.w = (float)u.w * (acc[i].w + b);
            st_h16x4(AX + off, o); }
    }
    __syncthreads();
}

__device__ __forceinline__ void final_norm_phase(const Ctx& C) {
    const int gw = C.vcu * NWAVES + C.wave, NGW = C.G * NWAVES, lane = C.lane;
    const float* rsq = C.ctlf + CW_RSQ_D; const float* g = C.in[21];
    for (int row = gw; row < M; row += NGW) {
        const float rstd = rsqrtf(rsq[row] * (1.0f / D) + EPS); float* xr = C.out + (size_t)row * D;
#pragma unroll
        for (int j = 0; j < 4; ++j) { const int col = j * 256 + lane * 4; const f32x4 v = *(const f32x4*)(xr + col), gg = *(const f32x4*)(g + col); *(f32x4*)(xr + col) = v * rstd * gg; }
    }
}


#define XB_TMO      128
#define XB_XCNT(j)  (256  + 64 * (j))
#define XB_XSUB(j)  (1280 + 64 * (j))
#define XB_XGEN(j)  (2304 + 64 * (j))
#define XB_TOP      3328
#define XB_TOPGEN   3392
#define XCD_BAR_WORDS 3456
#define XB_SPIN_CAP (1u << 20)
__device__ __forceinline__ unsigned xb_ld(unsigned* p)              { return __hip_atomic_load(p, __ATOMIC_RELAXED, __HIP_MEMORY_SCOPE_AGENT); }
__device__ __forceinline__ unsigned xb_add(unsigned* p, unsigned v) { return __hip_atomic_fetch_add(p, v, __ATOMIC_RELAXED, __HIP_MEMORY_SCOPE_AGENT); }
__device__ __forceinline__ unsigned xb_xcc_id() { return (unsigned)__builtin_amdgcn_s_getreg((3 << 11) | 20) & 0xFu; }
#define XB_SPIN(cond, bar) do { unsigned _sp = 0; while (cond) { __builtin_amdgcn_s_sleep(1); \
    if ((++_sp & 255u) == 0u) { if (xb_ld(&(bar)[XB_TMO])) break; if (_sp > XB_SPIN_CAP) { atomicAdd(&(bar)[XB_TMO], 1u); break; } } } } while (0)
struct XcdBarrier { unsigned* bar; unsigned x; volatile LAS unsigned* st; };
__device__ __forceinline__ XcdBarrier xcd_barrier_post(unsigned* bar, volatile LAS unsigned* st) {
    XcdBarrier b; b.bar = bar; b.x = xb_xcc_id(); b.st = st;
    if (threadIdx.x == 0) (void)xb_add(&bar[XB_XCNT(b.x)], 1u);
    return b;
}
__device__ __forceinline__ void xcd_barrier_complete(unsigned* bar, unsigned x, unsigned& nloc, unsigned& nx) {
    const unsigned G = gridDim.x * gridDim.y * gridDim.z;
    unsigned sum, cnt, mine, sp = 0u;
    for (;;) {
        sum = 0u; cnt = 0u; mine = 0u;
#pragma unroll
        for (unsigned j = 0; j < 16; ++j) { const unsigned c = xb_ld(&bar[XB_XCNT(j)]); sum += c; cnt += (c > 0u) ? 1u : 0u; mine = (j == x) ? c : mine; }
        if (sum == G) break;
        __builtin_amdgcn_s_sleep(1);
        if ((++sp & 255u) == 0u) { if (xb_ld(&bar[XB_TMO])) break; if (sp > XB_SPIN_CAP) { atomicAdd(&bar[XB_TMO], 1u); break; } }
    }
    nloc = mine > 0u ? mine : 1u; nx = cnt > 0u ? cnt : 1u;
}
__device__ __forceinline__ void xcd_barrier(const XcdBarrier& b) {
    asm volatile("s_waitcnt vmcnt(0)" ::: "memory");
    __syncthreads();
    if (threadIdx.x == 0) {
        unsigned* bar = b.bar;
        __builtin_amdgcn_s_waitcnt(0);
        unsigned nloc = b.st[0], nx = b.st[1];
        if (nloc == 0u) { xcd_barrier_complete(bar, b.x, nloc, nx); b.st[0] = nloc; b.st[1] = nx; }
        const unsigned old = xb_add(&bar[XB_XSUB(b.x)], 1u);
        const unsigned gen = old / nloc;
        if (old + 1u == (gen + 1u) * nloc) {
            __builtin_amdgcn_fence(__ATOMIC_RELEASE, "agent");
            asm volatile("s_waitcnt vmcnt(0)" ::: "memory");
            const unsigned og = xb_add(&bar[XB_TOP], 1u);
            const unsigned tg = og / nx;
            if (og + 1u == (tg + 1u) * nx) xb_add(&bar[XB_TOPGEN], 1u);
            else XB_SPIN(xb_ld(&bar[XB_TOPGEN]) == tg, bar);
            __builtin_amdgcn_fence(__ATOMIC_ACQUIRE, "agent");
            xb_add(&bar[XB_XGEN(b.x)], 1u);
            asm volatile("s_waitcnt vmcnt(0)" ::: "memory");
        } else {
            XB_SPIN(xb_ld(&bar[XB_XGEN(b.x)]) == gen, bar);
            __builtin_amdgcn_fence(__ATOMIC_ACQUIRE, "agent");
            asm volatile("s_waitcnt vmcnt(0)" ::: "memory");
        }
    }
    __syncthreads();
}

__global__ void __launch_bounds__(NTHREADS, 2) fwd_kernel(Args args) {
    extern __shared__ __attribute__((aligned(16))) unsigned char lds_raw[];
    Ctx C;
    C.lds = (LAS unsigned char*)lds_raw;
    C.tid = threadIdx.x; C.lane = C.tid & 63; C.wave = __builtin_amdgcn_readfirstlane(C.tid >> 6);
    C.G = gridDim.x; { const int bx = blockIdx.x; C.vcu = (C.G % 8 == 0) ? (bx % 8) * (C.G / 8) + bx / 8 : bx; }
    C.in = args.in; C.out = args.out; C.ws = args.ws;
    C.ctlf = (float*)(args.ws + WS_CTL); C.vec = (float*)(args.ws + WS_VEC);
    unsigned char* ws = args.ws;
    const int lo = args.ph_lo, hi = args.ph_hi;
    float* mod = C.ctlf + CW_MOD;
    h16* AX = (h16*)(ws + WS_AX); h16* AY = (h16*)(ws + WS_AY); h16* HID = (h16*)(ws + WS_HID);
    volatile LAS unsigned* MISC = (volatile LAS unsigned*)(C.lds + MISC_OFF);
    if (C.tid < 32) MISC[C.tid] = 0u;
    __syncthreads();
    XcdBarrier bar = xcd_barrier_post((unsigned*)C.ctlf + CW_BAR, MISC + 8);
#if MK_FAST_GEMM
#define GEMM_PHASE(PERM, A, W, Mr, N, K, E) fast_gemm_phase<decltype(E), PERM>(C, A, W, Mr, N, K, E)
#else
#define GEMM_PHASE(PERM, A, W, Mr, N, K, E) naive_gemm_phase(C, A, W, Mr, N, K, E)
#endif
#define IN(k) (lo <= (k) && (k) < hi)
#define SEAM(k) do { if (IN(k) && IN((k) + 1)) xcd_barrier(bar); } while (0)
    if (IN(0)) { phase0(C); SEAM(0); }
    if (IN(1)) { phase1(C); SEAM(1); }
    if (IN(2)) { EpiWin E{(h16*)(ws + WS_Q), (h16*)C.out, (h16*)C.out + (size_t)M * D, (bf16_t*)(ws + WS_V), (h16*)(ws + WS_G)};
        GEMM_PHASE(true, AX, (const h16*)(ws + WS_W_HIN), M, N_HIN, D, E); SEAM(2); }
    if (IN(3)) { naive_scan_phase(C); SEAM(3); }
    if (IN(4)) { naive_combine_phase(C); SEAM(4); }
    if (IN(5)) { EpiRes E{C.in[0], C.in[1], C.out, mod + 2 * D, C.vec + VW_GN, AY, C.ctlf + CW_RSQ_A};
        GEMM_PHASE(false, AX, (const h16*)(ws + WS_W_HOUT), M, D, D, E); SEAM(5); }
    if (IN(6)) { EpiHid E{C.ctlf + CW_RSQ_A, C.vec + VW_BMLP, HID};
        GEMM_PHASE(true, AY, (const h16*)(ws + WS_W_W1), M, FF, D, E); SEAM(6); }
    if (IN(7)) { EpiRes E{nullptr, nullptr, C.out, mod + 5 * D, C.vec + VW_GN + NCOND * D, AY, C.ctlf + CW_RSQ_B};
        GEMM_PHASE(false, HID, (const h16*)(ws + WS_W_W2), M, D, FF, E); SEAM(7); }
    if (IN(8)) { EpiCin E{C.ctlf + CW_RSQ_B, C.vec + VW_BCM, (h16*)(ws + WS_U), (h16*)(ws + WS_V2), C.ctlf + CW_VS1, C.ctlf + CW_VS2};
        GEMM_PHASE(true, AY, (const h16*)(ws + WS_W_CIN), M, N_CIN, D, E); SEAM(8); }
    if (IN(9)) { naive_spatial_phase(C); SEAM(9); }
    if (IN(10)) { EpiRes E{nullptr, nullptr, C.out, mod + (size_t)NCOND * 6 * D + 2 * D, C.vec + VW_GN + 2 * NCOND * D, AY, C.ctlf + CW_RSQ_C};
        GEMM_PHASE(false, AX, (const h16*)(ws + WS_W_COUT), M, D, D, E); SEAM(10); }
    if (IN(11)) { EpiHid E{C.ctlf + CW_RSQ_C, C.vec + VW_BMLP + NCOND * FF, HID};
        GEMM_PHASE(true, AY, (const h16*)(ws + WS_W_W1 + 8 * MiB), M, FF, D, E); SEAM(11); }
    if (IN(12)) { EpiRes E{nullptr, nullptr, C.out, mod + (size_t)NCOND * 6 * D + 5 * D, nullptr, nullptr, C.ctlf + CW_RSQ_D};
        GEMM_PHASE(false, HID, (const h16*)(ws + WS_W_W2 + 8 * MiB), M, D, FF, E); SEAM(12); }
    if (IN(13)) { final_norm_phase(C); }
#undef IN
#undef SEAM
}


extern "C" void kernel_launch(void* const* d_in, const int* in_sizes, int n_in, void* d_out, int out_size, void* d_ws, size_t ws_size, hipStream_t stream) {
    static int grid = 0;
    if (grid == 0) {
        if (n_in != 22 || ws_size < WS_END) { fprintf(stderr, "kernel_launch: unexpected shapes (n_in %d, ws %zu)\n", n_in, ws_size); grid = -1; return; }
        int dev = 0, cus = 0;
        if (hipGetDevice(&dev) != hipSuccess || hipDeviceGetAttribute(&cus, hipDeviceAttributeMultiprocessorCount, dev) != hipSuccess) { grid = -1; return; }
        if (hipFuncSetAttribute((const void*)fwd_kernel, hipFuncAttributeMaxDynamicSharedMemorySize, LDS_BYTES) != hipSuccess) { fprintf(stderr, "kernel_launch: hipFuncSetAttribute failed\n"); grid = -1; return; }
        grid = cus;
    }
    if (grid < 0) return;
    (void)hipMemsetAsync((char*)d_ws + WS_CTL, 0, CTL_ZERO_BYTES, stream);
    Args a{};
    for (int i = 0; i < 22; ++i) a.in[i] = (const float*)d_in[i];
    a.out = (float*)d_out; a.ws = (unsigned char*)d_ws;
#if MK_LAUNCH_PER_PHASE
    for (int p = 0; p < NPHASES; ++p) { a.ph_lo = p; a.ph_hi = p + 1; hipLaunchKernelGGL(fwd_kernel, dim3(grid), dim3(NTHREADS), LDS_BYTES, stream, a); }
#else
    a.ph_lo = 0; a.ph_hi = NPHASES; hipLaunchKernelGGL(fwd_kernel, dim3(grid), dim3(NTHREADS), LDS_BYTES, stream, a);
#endif
}
```

```cpp
#include <hip/hip_runtime.h>
#include <cstdio>
#include <cstdint>

#ifndef MK_FAST_GEMM
#define MK_FAST_GEMM 1
#endif
#ifndef MK_SCAN_HYBRID
#define MK_SCAN_HYBRID 0
#endif
#ifndef MK_SCAN_DBG
#define MK_SCAN_DBG 0
#endif
#ifndef MK_FAST_SCAN
#define MK_FAST_SCAN 1
#endif
#ifndef MK_LAUNCH_PER_PHASE
#define MK_LAUNCH_PER_PHASE 0
#endif

#define GAS __attribute__((address_space(1)))
#define LAS __attribute__((address_space(3)))
typedef _Float16 h16;
typedef _Float16 h16x2 __attribute__((ext_vector_type(2)));
typedef _Float16 h16x4 __attribute__((ext_vector_type(4)));
typedef _Float16 h16x8 __attribute__((ext_vector_type(8)));
typedef float f32x2 __attribute__((ext_vector_type(2)));
typedef float f32x4 __attribute__((ext_vector_type(4)));
typedef unsigned u32x2 __attribute__((ext_vector_type(2)));
typedef unsigned u32x4 __attribute__((ext_vector_type(4)));
typedef unsigned short bf16_t;
typedef __bf16 bf16x2_t __attribute__((ext_vector_type(2)));

constexpr int D = 1024, M_CTX = 4096, M_LAT = 16384, M = M_CTX + M_LAT, FF = 4096, NCOND = 5, NH = 8, HD = 128;
constexpr int N_HIN = 5 * D, N_CIN = 2 * D;
constexpr float EPS = 1e-6f;
constexpr int NWAVES = 8, NTHREADS = 512, NPHASES = 14;
constexpr int LDS_BYTES = 147456, MISC_OFF = 131072 + 320;

constexpr size_t MiB = 1u << 20;
constexpr size_t WS_CTL = 0, CTL_ZERO_BYTES = 1 * MiB;
constexpr int CW_TMO = 0, CW_BAR = 1024, CW_MOD = 8192, CW_RSQ_A = CW_MOD + 2 * NCOND * 6 * D, CW_RSQ_B = CW_RSQ_A + M, CW_RSQ_C = CW_RSQ_B + M,
              CW_RSQ_D = CW_RSQ_C + M, CW_VS1 = CW_RSQ_D + M, CW_VS2 = CW_VS1 + M, CW_END = CW_VS2 + M;
static_assert((size_t)CW_END * 4 <= CTL_ZERO_BYTES, "ctl words");
constexpr size_t WS_VEC = 1 * MiB;
constexpr int VW_GN = 0  , VW_BMLP = VW_GN + 3 * NCOND * D  , VW_BCM = VW_BMLP + 2 * NCOND * FF  , VW_LB = VW_BCM + NCOND * N_CIN  , VW_END = VW_LB + 2 * D;
static_assert((size_t)VW_END * 4 <= MiB, "vec words");
constexpr size_t WS_W_HIN = 2 * MiB, WS_W_HOUT = 12 * MiB, WS_W_CIN = 14 * MiB, WS_W_COUT = 18 * MiB, WS_W_W1 = 20 * MiB  , WS_W_W2 = 36 * MiB  , WS_W_WS = 52 * MiB;
constexpr size_t WS_AY = 54 * MiB, WS_AX = 94 * MiB, WS_Q = 134 * MiB, WS_V = 174 * MiB, WS_G = 214 * MiB, WS_END = 254 * MiB;
constexpr size_t WS_HID = WS_AX;
constexpr size_t WS_U = WS_Q, WS_V2 = WS_V;
constexpr size_t ACT_BYTES = (size_t)M * D * 2;
static_assert(ACT_BYTES == 40 * MiB && WS_HID + (size_t)M * FF * 2 == WS_END, "map");

__device__ __forceinline__ float ex2(float x) { return __builtin_amdgcn_exp2f(x); }
__device__ __forceinline__ float rcpf(float x) { return __builtin_amdgcn_rcpf(x); }
__device__ __forceinline__ float sigmoidf_(float x) { return rcpf(1.0f + ex2(-1.4426950408889634f * x)); }
__device__ __forceinline__ float siluf_(float x) { return x * sigmoidf_(x); }
__device__ __forceinline__ float gelu_tanh(float x) { const float y = 0.7978845608028654f * (x + 0.044715f * x * x * x); const float t = 1.0f - 2.0f * rcpf(1.0f + ex2(2.885390081777927f * y)); return 0.5f * x * (1.0f + t); }
__device__ __forceinline__ float bf2f(bf16_t b) { return __uint_as_float((unsigned)b << 16); }
__device__ __forceinline__ unsigned pk_bf16(float lo, float hi) { f32x2 v = {lo, hi}; bf16x2_t b = __builtin_convertvector(v, bf16x2_t); return __builtin_bit_cast(unsigned, b); }
__device__ __forceinline__ unsigned pk_h16(float lo, float hi) { f32x2 v = {lo, hi}; h16x2 b = __builtin_convertvector(v, h16x2); return __builtin_bit_cast(unsigned, b); }
__device__ __forceinline__ void st_h16x4(h16* p, f32x4 v) { u32x2 w; w.x = pk_h16(v.x, v.y); w.y = pk_h16(v.z, v.w); *(u32x2*)p = w; }
__device__ __forceinline__ void st_bf16x4(bf16_t* p, f32x4 v) { u32x2 w; w.x = pk_bf16(v.x, v.y); w.y = pk_bf16(v.z, v.w); *(u32x2*)p = w; }
__device__ __forceinline__ float wave_sum(float v) {
#pragma unroll
    for (int o = 1; o < 64; o <<= 1) v += __shfl_xor(v, o);
    return v;
}
__device__ __forceinline__ int cond_of_row(int row) { return row < M_CTX ? 0 : 1 + ((row - M_CTX) >> 12); }

struct Args { const float* in[22]; float* out; unsigned char* ws; int ph_lo, ph_hi; };

struct Ctx {
    LAS unsigned char* lds;
    int tid, lane, wave, vcu, G;
    const float* const* in; float* out; unsigned char* ws;
    float* ctlf; float* vec;
};

struct EpiWin {
    static constexpr bool STATS = false;
    h16* Q; h16* ZF; h16* ZB; bf16_t* V; h16* Gt;
    __device__ __forceinline__ void apply(int row, int col, f32x4 a, float&, float&) const {
        const int grp = col >> 10, cc = col & 1023; const size_t off = (size_t)row * D + cc;
        if (grp == 0) { f32x4 s = {siluf_(a.x), siluf_(a.y), siluf_(a.z), siluf_(a.w)}; st_h16x4(Q + off, s); }
        else if (grp == 1) st_h16x4(ZF + off, a);
        else if (grp == 2) st_h16x4(ZB + off, a);
        else if (grp == 3) st_bf16x4(V + off, a);
        else { f32x4 s = {siluf_(a.x), siluf_(a.y), siluf_(a.z), siluf_(a.w)}; st_h16x4(Gt + off, s); }
    }
    __device__ __forceinline__ void commit(int, int, float, float) const {}
};
struct EpiRes {
    static constexpr bool STATS = true;
    const float* xp; const float* xs;
    float* out; const float* gate;
    const float* gn; h16* Aout;
    float* rsq;
    __device__ __forceinline__ void apply(int row, int col, f32x4 a, float&, float& s2) const {
        const int cond = cond_of_row(row); const size_t off = (size_t)row * D + col;
        const float* xo = xp ? (row < M_CTX ? xp + off : xs + (off - (size_t)M_CTX * D)) : out + off;
        const f32x4 x0 = *(const f32x4*)xo, g = *(const f32x4*)(gate + cond * 6 * D + col);
        const f32x4 xn = x0 + g * a;
        *(f32x4*)(out + off) = xn;
        s2 += (xn.x * xn.x + xn.y * xn.y) + (xn.z * xn.z + xn.w * xn.w);
        if (Aout) { const f32x4 gv = *(const f32x4*)(gn + cond * D + col); st_h16x4(Aout + off, xn * gv); }
    }
    __device__ __forceinline__ void commit(int row, int, float, float s2) const { atomicAdd(rsq + row, s2); }
};
struct EpiHid {
    static constexpr bool STATS = false;
    const float* rsq; const float* bias; h16* H;
    __device__ __forceinline__ void apply(int row, int col, f32x4 a, float&, float&) const {
        const int cond = cond_of_row(row); const float rstd = rsqrtf(rsq[row] * (1.0f / D) + EPS);
        const f32x4 b = *(const f32x4*)(bias + cond * FF + col);
        f32x4 z = a * rstd + b; z.x = fmaxf(z.x, 0.f); z.y = fmaxf(z.y, 0.f); z.z = fmaxf(z.z, 0.f); z.w = fmaxf(z.w, 0.f);
        st_h16x4(H + (size_t)row * FF + col, z * z);
    }
    __device__ __forceinline__ void commit(int, int, float, float) const {}
};
struct EpiCin {
    static constexpr bool STATS = true;
    const float* rsq; const float* bias; h16* U; h16* V2; float* vs1; float* vs2;
    __device__ __forceinline__ void apply(int row, int col, f32x4 a, float& s1, float& s2) const {
        const int cond = cond_of_row(row); const float rstd = rsqrtf(rsq[row] * (1.0f / D) + EPS);
        const f32x4 b = *(const f32x4*)(bias + cond * N_CIN + col);
        f32x4 z = a * rstd + b; z.x = gelu_tanh(z.x); z.y = gelu_tanh(z.y); z.z = gelu_tanh(z.z); z.w = gelu_tanh(z.w);
        if (col < D) st_h16x4(U + (size_t)row * D + col, z);
        else { st_h16x4(V2 + (size_t)row * D + (col - D), z); s1 += (z.x + z.y) + (z.z + z.w); s2 += (z.x * z.x + z.y * z.y) + (z.z * z.z + z.w * z.w); }
    }
    __device__ __forceinline__ void commit(int row, int col, float s1, float s2) const { if (col >= D) { atomicAdd(vs1 + row, s1); atomicAdd(vs2 + row, s2); } }
};

template <class Epi>
__device__ __forceinline__ void naive_gemm_phase(const Ctx& C, const h16* A, const h16* Wt, int Mr, int N, int K, const Epi& E) {
    LAS float* As = (LAS float*)C.lds; LAS float* Bs = As + 16 * 132;
    const int tid = C.tid, ty = tid >> 5, tx = tid & 31;
    const int ntn = N / 128, ntiles = (Mr / 128) * ntn;
    for (int t = C.vcu; t < ntiles; t += C.G) {
        const int pm = t / ntn, pn = t % ntn;
        f32x4 acc[8];
#pragma unroll
        for (int i = 0; i < 8; ++i) acc[i] = (f32x4){0.f, 0.f, 0.f, 0.f};
        const int r = tid >> 2, kk = (tid & 3) * 4;
        const h16* ap = A + (size_t)(pm * 128 + r) * K + kk; const h16* bp = Wt + (size_t)(pn * 128 + r) * K + kk;
        for (int k0 = 0; k0 < K; k0 += 16) {
            const h16x4 a = *(const h16x4*)(ap + k0), b = *(const h16x4*)(bp + k0);
            __syncthreads();
#pragma unroll
            for (int j = 0; j < 4; ++j) { As[(kk + j) * 132 + r] = (float)a[j]; Bs[(kk + j) * 132 + r] = (float)b[j]; }
            __syncthreads();
#pragma unroll 2
            for (int k = 0; k < 16; ++k) {
                const f32x4 a0 = *(LAS f32x4*)(As + k * 132 + ty * 8), a1 = *(LAS f32x4*)(As + k * 132 + ty * 8 + 4), bv = *(LAS f32x4*)(Bs + k * 132 + tx * 4);
                acc[0] += a0.x * bv; acc[1] += a0.y * bv; acc[2] += a0.z * bv; acc[3] += a0.w * bv;
                acc[4] += a1.x * bv; acc[5] += a1.y * bv; acc[6] += a1.z * bv; acc[7] += a1.w * bv;
            }
        }
#pragma unroll
        for (int i = 0; i < 8; ++i) { float s1 = 0.f, s2 = 0.f; const int row = pm * 128 + ty * 8 + i, col = pn * 128 + tx * 4; E.apply(row, col, acc[i], s1, s2); E.commit(row, col, s1, s2); }
    }
    __syncthreads();
}


namespace pg8 {
constexpr int BM = 256, BK = 64, HALF = 128, HTB = HALF * BK * 2, STAGE_BYTES = 8 * HTB, NXCD = 8, WGM = 8;
__host__ __device__ __forceinline__ int lds_byte(int r, int c) { const int st = (r >> 4) * 2 + (c >> 5), rr = r & 15, cc = c & 31, ob = rr * 64 + cc * 2; return st * 1024 + (ob ^ (((ob >> 9) & 1) << 5)); }
__host__ __device__ __forceinline__ void stage_rc(int b, int& R, int& C) { const int st = b / 1024, sb = b % 1024, swz = sb ^ (((sb >> 9) & 1) << 5); R = (st >> 1) * 16 + swz / 64; C = (st & 1) * 32 + (swz % 64) / 2; }
__host__ __device__ __forceinline__ int perm32(int rho) { const int n = rho >> 4, i = rho & 15; return 8 * (i >> 2) + 4 * n + (i & 3); }
struct Unit { int pm, pn; };
struct StaticOrder {
    int nM, nN, nwg, G, c;
    __host__ __device__ void init(int M_, int N_, int G_, int c_) { nM = M_ / BM; nN = N_ / BM; nwg = nM * nN; G = G_; c = c_; }
    __host__ __device__ bool next(int i, Unit& u) const {
        const long L = (long)i * G + c; if (L >= nwg) return false;
        int wgid = (int)L; { const int q = nwg / NXCD, r = nwg % NXCD, xcd = wgid % NXCD, off = wgid / NXCD; wgid = (xcd < r ? xcd * (q + 1) : r * (q + 1) + (xcd - r) * q) + off; }
        const int nig = WGM * nN, gid = wgid / nig, fm = gid * WGM, gsz = (nM - fm) < WGM ? (nM - fm) : WGM;
        u.pm = fm + ((wgid % nig) % gsz); u.pn = (wgid % nig) / gsz; return true;
    }
};
template <class Epi, bool PERM>
__device__ __forceinline__ void run_epi(const Epi& E, const f32x4 (&acc)[2][2][4][2], const Unit& u, int wr, int wc, int fr, int fq) {
#pragma unroll
    for (int ai = 0; ai < 2; ++ai)
#pragma unroll
        for (int m = 0; m < 4; ++m) {
            const int row = u.pm * BM + ai * HALF + wr * 64 + m * 16 + fr; float s1 = 0.f, s2 = 0.f;
#pragma unroll
            for (int bj = 0; bj < 2; ++bj)
#pragma unroll
                for (int n = 0; n < 2; ++n) { const int col = u.pn * BM + bj * HALF + wc * 32 + (PERM ? 8 * fq + 4 * n : 16 * n + 4 * fq); E.apply(row, col, acc[ai][bj][m][n], s1, s2); }
            if (Epi::STATS) { s1 += __shfl_xor(s1, 16); s1 += __shfl_xor(s1, 32); s2 += __shfl_xor(s2, 16); s2 += __shfl_xor(s2, 32); if (fq == 0) E.commit(row, u.pn * BM, s1, s2); }
        }
}
template <class Epi, bool PERM>
__device__ __forceinline__ void gemm_phase(LAS unsigned char* lds, const h16* Ag, const h16* Btg, int K, const StaticOrder& S, const Epi& E) {
    const int tid = threadIdx.x, wid = __builtin_amdgcn_readfirstlane(tid >> 6), lane = tid & 63, wr = wid >> 2, wc = wid & 3, fr = lane & 15, fq = lane >> 4;
    const int nt = K / BK;
    unsigned voffA[2], voffB[2];
#pragma unroll
    for (int i = 0; i < 2; ++i) { int R, Cc; stage_rc(tid * 16 + i * 8192, R, Cc); const int Rb = PERM ? ((R & ~31) + perm32(R & 31)) : R;
        voffA[i] = (unsigned)(R * K + Cc) * 2u; voffB[i] = (unsigned)(Rb * K + Cc) * 2u; }
    const size_t kstep = (size_t)(BK * 2), hstep = (size_t)HALF * K * 2, tstep = 2 * hstep;
    const unsigned ldsw = (unsigned)wid * 1024u;
    const int aoff = lds_byte(wr * 64 + fr, fq * 8), boff = lds_byte(wc * 32 + fr, fq * 8);
#define PG8_SA(b, h) (((b) * 2 + (h)) * HTB)
#define PG8_SB(b, h) ((4 + (b) * 2 + (h)) * HTB)
#define PG8_STAGE(bufoff, gbase, voff) do { _Pragma("unroll") for (int _i = 0; _i < 2; ++_i) \
        __builtin_amdgcn_global_load_lds((const unsigned*)((const char*)(gbase) + (voff)[_i]), (LAS unsigned*)(lds + (bufoff) + ldsw + _i * 8192), 16, 0, 0); } while (0)
#define PG8_LDA(dst, b, h) do { _Pragma("unroll") for (int m = 0; m < 4; ++m) _Pragma("unroll") for (int k = 0; k < 2; ++k) dst[m][k] = *(const LAS h16x8*)(lds + PG8_SA(b, h) + aoff + m * 2048 + k * 1024); } while (0)
#define PG8_LDB(dst, b, h) do { _Pragma("unroll") for (int n = 0; n < 2; ++n) _Pragma("unroll") for (int k = 0; k < 2; ++k) dst[n][k] = *(const LAS h16x8*)(lds + PG8_SB(b, h) + boff + n * 2048 + k * 1024); } while (0)
#define PG8_MMA(ai, bj, At, Bt) do { __builtin_amdgcn_s_setprio(1); _Pragma("unroll") for (int m = 0; m < 4; ++m) _Pragma("unroll") for (int n = 0; n < 2; ++n) _Pragma("unroll") for (int k = 0; k < 2; ++k) \
        acc[ai][bj][m][n] = __builtin_amdgcn_mfma_f32_16x16x32_f16(Bt[n][k], At[m][k], acc[ai][bj][m][n], 0, 0, 0); __builtin_amdgcn_s_setprio(0); } while (0)
#define PG8_WAIT_V(n) asm volatile("s_waitcnt vmcnt(" #n ")" ::: "memory")
#define PG8_WAIT_L(n) asm volatile("s_waitcnt lgkmcnt(" #n ")" ::: "memory")
#define PG8_BAR __builtin_amdgcn_s_barrier()
#define PG8_SCHED __builtin_amdgcn_sched_barrier(0)
    Unit cur, nxt; int ui = 0;
    if (!S.next(0, cur)) return;
    f32x4 acc[2][2][4][2];
#pragma unroll
    for (int a = 0; a < 2; ++a)
#pragma unroll
        for (int b = 0; b < 2; ++b)
#pragma unroll
            for (int m = 0; m < 4; ++m)
#pragma unroll
                for (int n = 0; n < 2; ++n) acc[a][b][m][n] = (f32x4){0.f, 0.f, 0.f, 0.f};
    h16x8 At[4][2], B0[2][2], B1[2][2];
    const char* cA = (const char*)Ag + (size_t)cur.pm * tstep; const char* cB = (const char*)Btg + (size_t)cur.pn * tstep;
    PG8_STAGE(PG8_SB(0, 0), cB, voffB); PG8_STAGE(PG8_SB(0, 1), cB + hstep, voffB); PG8_STAGE(PG8_SA(0, 0), cA, voffA); PG8_STAGE(PG8_SA(0, 1), cA + hstep, voffA);
    if (wr == 1) PG8_BAR;
    PG8_WAIT_V(2); PG8_BAR;
    PG8_STAGE(PG8_SB(1, 0), cB + kstep, voffB); PG8_STAGE(PG8_SA(1, 0), cA + kstep, voffA); PG8_STAGE(PG8_SB(1, 1), cB + hstep + kstep, voffB);
    PG8_WAIT_V(6); PG8_BAR;
    for (;;) {
        const bool has_next = S.next(ui + 1, nxt);
        const char* nA = has_next ? (const char*)Ag + (size_t)nxt.pm * tstep : cA; const char* nB = has_next ? (const char*)Btg + (size_t)nxt.pn * tstep : cB;
        for (int t = 0; t < nt; t += 2) {
            const bool last = (t == nt - 2);
            const char* a1 = cA + (size_t)(t + 1) * kstep;
            const char* a2 = last ? nA : cA + (size_t)(t + 2) * kstep; const char* b2 = last ? nB : cB + (size_t)(t + 2) * kstep;
            const char* a3 = a2 + kstep; const char* b3 = b2 + kstep;
            PG8_LDB(B0, 0, 0); PG8_LDB(B1, 0, 1); PG8_SCHED; PG8_LDA(At, 0, 0); PG8_STAGE(PG8_SA(1, 1), a1 + hstep, voffA);
            PG8_WAIT_V(8); PG8_WAIT_L(0); PG8_BAR; PG8_MMA(0, 0, At, B0); PG8_MMA(0, 1, At, B1); PG8_BAR; PG8_SCHED;
            PG8_LDA(At, 0, 1); PG8_STAGE(PG8_SB(0, 0), b2, voffB); PG8_STAGE(PG8_SB(0, 1), b2 + hstep, voffB); PG8_STAGE(PG8_SA(0, 0), a2, voffA);
            PG8_WAIT_V(8); PG8_WAIT_L(0); PG8_BAR; PG8_MMA(1, 0, At, B0); PG8_MMA(1, 1, At, B1); PG8_BAR; PG8_SCHED;
            PG8_LDB(B0, 1, 0); PG8_LDB(B1, 1, 1); PG8_SCHED; PG8_LDA(At, 1, 0); PG8_STAGE(PG8_SA(0, 1), a2 + hstep, voffA);
            PG8_WAIT_V(8); PG8_WAIT_L(0); PG8_BAR; PG8_MMA(0, 0, At, B0); PG8_MMA(0, 1, At, B1); PG8_BAR; PG8_SCHED;
            PG8_LDA(At, 1, 1); PG8_STAGE(PG8_SB(1, 0), b3, voffB); PG8_STAGE(PG8_SB(1, 1), b3 + hstep, voffB); PG8_STAGE(PG8_SA(1, 0), a3, voffA);
            PG8_WAIT_V(8); PG8_WAIT_L(0); PG8_BAR; PG8_MMA(1, 0, At, B0); PG8_MMA(1, 1, At, B1); PG8_BAR; PG8_SCHED;
        }
        if (wr == 0) PG8_BAR;
        run_epi<Epi, PERM>(E, acc, cur, wr, wc, fr, fq);
        if (!has_next) break;
#pragma unroll
        for (int a = 0; a < 2; ++a)
#pragma unroll
            for (int b = 0; b < 2; ++b)
#pragma unroll
                for (int m = 0; m < 4; ++m)
#pragma unroll
                    for (int n = 0; n < 2; ++n) acc[a][b][m][n] = (f32x4){0.f, 0.f, 0.f, 0.f};
        cur = nxt; cA = nA; cB = nB; ++ui;
        if (wr == 1) PG8_BAR;
    }
    PG8_WAIT_V(0);
    PG8_BAR;
#undef PG8_SA
#undef PG8_SB
#undef PG8_STAGE
#undef PG8_LDA
#undef PG8_LDB
#undef PG8_MMA
#undef PG8_WAIT_V
#undef PG8_WAIT_L
#undef PG8_BAR
#undef PG8_SCHED
}
}
template <class Epi, bool PERM>
__device__ __forceinline__ void fast_gemm_phase(const Ctx& C, const h16* A, const h16* Wt, int Mr, int N, int K, const Epi& E) {
    pg8::StaticOrder S; S.init(Mr, N, C.G, (int)blockIdx.x);
    pg8::gemm_phase<Epi, PERM>(C.lds, A, Wt, K, S, E);
    __syncthreads();
}

__device__ __forceinline__ void p0_transpose_item(const float* W, int K, int N, h16* WT, LAS float* scr, int item, int lane) {
    const int nblk = N / 32, kb = item / nblk, nb = item % nblk, k0 = 64 * kb, n0 = 32 * nb;
#pragma unroll 8
    for (int i = 0; i < 32; ++i) { const int kk = 2 * i + (lane >> 5); scr[kk * 33 + (lane & 31)] = W[(size_t)(k0 + kk) * N + n0 + (lane & 31)]; }
    asm volatile("s_waitcnt lgkmcnt(0)" ::: "memory");
    const int c = lane & 7;
#pragma unroll
    for (int j = 0; j < 4; ++j) { const int n = (lane >> 3) + 8 * j; const LAS float* s = scr + (8 * c) * 33 + n;
        u32x4 o; o.x = pk_h16(s[0 * 33], s[1 * 33]); o.y = pk_h16(s[2 * 33], s[3 * 33]); o.z = pk_h16(s[4 * 33], s[5 * 33]); o.w = pk_h16(s[6 * 33], s[7 * 33]);
        *(u32x4*)(WT + (size_t)(n0 + n) * K + k0 + 8 * c) = o; }
    asm volatile("s_waitcnt lgkmcnt(0)" ::: "memory");
}
__device__ __forceinline__ void phase0(const Ctx& C) {
    LAS float* scr = (LAS float*)(C.lds + C.wave * 16384);
    const int gw = C.vcu * NWAVES + C.wave, NGW = C.G * NWAVES;
    unsigned char* ws = C.ws;
    constexpr int I_HIN = (D / 64) * (N_HIN / 32), I_DD = (D / 64) * (D / 32), I_CIN = (D / 64) * (N_CIN / 32), I_W1 = (D / 64) * (FF / 32), I_W2 = (FF / 64) * (D / 32);
    constexpr int NITEMS = I_HIN + 2 * I_DD + I_CIN + 2 * I_W1 + 2 * I_W2;
    for (int it = gw; it < NITEMS; it += NGW) {
        int r = it;
        if (r < I_HIN) { p0_transpose_item(C.in[11], D, N_HIN, (h16*)(ws + WS_W_HIN), scr, r, C.lane); continue; } r -= I_HIN;
        if (r < I_DD) { p0_transpose_item(C.in[14], D, D, (h16*)(ws + WS_W_HOUT), scr, r, C.lane); continue; } r -= I_DD;
        if (r < I_CIN) { p0_transpose_item(C.in[15], D, N_CIN, (h16*)(ws + WS_W_CIN), scr, r, C.lane); continue; } r -= I_CIN;
        if (r < I_DD) { p0_transpose_item(C.in[20], D, D, (h16*)(ws + WS_W_COUT), scr, r, C.lane); continue; } r -= I_DD;
        if (r < 2 * I_W1) { const int l = r / I_W1; p0_transpose_item(C.in[9] + (size_t)l * D * FF, D, FF, (h16*)(ws + WS_W_W1 + (size_t)l * 8 * MiB), scr, r % I_W1, C.lane); continue; } r -= 2 * I_W1;
        { const int l = r / I_W2; p0_transpose_item(C.in[10] + (size_t)l * FF * D, FF, D, (h16*)(ws + WS_W_W2 + (size_t)l * 8 * MiB), scr, r % I_W2, C.lane); }
    }
    { const float* src = C.in[18]; h16* dst = (h16*)(ws + WS_W_WS);
      for (int i = (gw * 64 + C.lane) * 4; i < 8 * 128 * 128; i += NGW * 64 * 4) st_h16x4(dst + i, *(const f32x4*)(src + i)); }
    float* mod = C.ctlf + CW_MOD;
    for (int task = gw; task < 2 * 32 * 24; task += NGW) {
        const int l = task / (32 * 24), rem = task % (32 * 24), kc = rem / 24, cb = rem % 24;
        const int col = cb * 256 + C.lane * 4, k0 = kc * 32;
        const float* W = C.in[5] + (size_t)l * D * 6 * D;
        f32x4 acc[NCOND];
#pragma unroll
        for (int c = 0; c < NCOND; ++c) acc[c] = (f32x4){0.f, 0.f, 0.f, 0.f};
        for (int kk = 0; kk < 32; ++kk) {
            const f32x4 w = *(const f32x4*)(W + (size_t)(k0 + kk) * 6 * D + col);
#pragma unroll
            for (int c = 0; c < NCOND; ++c) { const float cv = (c == 0) ? C.in[4][k0 + kk] : C.in[3][(c - 1) * D + k0 + kk]; acc[c] += siluf_(cv) * w; }
        }
        if (kc == 0) { const f32x4 b = *(const f32x4*)(C.in[6] + (size_t)l * 6 * D + col);
#pragma unroll
            for (int c = 0; c < NCOND; ++c) acc[c] += b; }
#pragma unroll
        for (int c = 0; c < NCOND; ++c) { float* p = mod + ((size_t)l * NCOND + c) * 6 * D + col; atomicAdd(p, acc[c].x); atomicAdd(p + 1, acc[c].y); atomicAdd(p + 2, acc[c].z); atomicAdd(p + 3, acc[c].w); }
    }
}

__device__ __forceinline__ void phase1(const Ctx& C) {
    const int gw = C.vcu * NWAVES + C.wave, NGW = C.G * NWAVES, lane = C.lane;
    const float* mod = C.ctlf + CW_MOD; float* vec = C.vec; unsigned char* ws = C.ws;
    h16* AX = (h16*)(ws + WS_AX);
    const float* g0 = C.in[7];
    for (int row = gw; row < M; row += NGW) {
        const float* xr = row < M_CTX ? C.in[0] + (size_t)row * D : C.in[1] + (size_t)(row - M_CTX) * D;
        const float* mc = mod + (size_t)cond_of_row(row) * 6 * D;
        f32x4 v[4]; float s = 0.f;
#pragma unroll
        for (int j = 0; j < 4; ++j) { v[j] = *(const f32x4*)(xr + j * 256 + lane * 4); s += (v[j].x * v[j].x + v[j].y * v[j].y) + (v[j].z * v[j].z + v[j].w * v[j].w); }
        const float rstd = rsqrtf(wave_sum(s) * (1.0f / D) + EPS);
#pragma unroll
        for (int j = 0; j < 4; ++j) { const int col = j * 256 + lane * 4;
            const f32x4 g = *(const f32x4*)(g0 + col), sh = *(const f32x4*)(mc + col), sc = *(const f32x4*)(mc + D + col);
            st_h16x4(AX + (size_t)row * D + col, v[j] * rstd * g * (sc + 1.0f) + sh); }
    }
    for (int i = gw * 64 + lane; i < 3 * NCOND * D; i += NGW * 64) {
        const int vI = i / (NCOND * D), c = (i / D) % NCOND, col = i % D;
        const float g = vI == 0 ? C.in[8][col] : (vI == 1 ? C.in[7][D + col] : C.in[8][D + col]);
        const int l = vI == 0 ? 0 : 1, slot = vI == 1 ? 1 : 4;
        vec[VW_GN + i] = g * (1.0f + mod[((size_t)l * NCOND + c) * 6 * D + slot * D + col]);
    }
    for (int i = gw * 64 + lane; i < 2 * D; i += NGW * 64) { const float l0 = C.in[12][i], l1 = C.in[12][2 * D + i]; vec[VW_LB + i] = 1.0f / (1.0f + __expf(l1 - l0)); }
    constexpr int NB = 2 * FF + N_CIN;
    for (int task = gw; task < NB; task += NGW) {
        const h16* wrow; const float* sh; float* dst; int stride;
        if (task < FF) { wrow = (const h16*)(ws + WS_W_W1) + (size_t)task * D; sh = mod + 3 * D; dst = vec + VW_BMLP + task; stride = FF; }
        else if (task < 2 * FF) { const int n = task - FF; wrow = (const h16*)(ws + WS_W_W1 + 8 * MiB) + (size_t)n * D; sh = mod + (size_t)NCOND * 6 * D + 3 * D; dst = vec + VW_BMLP + NCOND * FF + n; stride = FF; }
        else { const int n = task - 2 * FF; wrow = (const h16*)(ws + WS_W_CIN) + (size_t)n * D; sh = mod + (size_t)NCOND * 6 * D; dst = vec + VW_BCM + n; stride = N_CIN; }
        float w[16];
        { const h16x8 a = *(const h16x8*)(wrow + lane * 8), b = *(const h16x8*)(wrow + 512 + lane * 8);
#pragma unroll
          for (int j = 0; j < 8; ++j) { w[j] = (float)a[j]; w[8 + j] = (float)b[j]; } }
#pragma unroll
        for (int c = 0; c < NCOND; ++c) { const float* s = sh + (size_t)c * 6 * D; float p = 0.f;
#pragma unroll
            for (int j = 0; j < 8; ++j) { p += w[j] * s[lane * 8 + j]; p += w[8 + j] * s[512 + lane * 8 + j]; }
            p = wave_sum(p); if (lane == 0) dst[(size_t)c * stride] = p; }
    }
}

__device__ __forceinline__ void naive_scan_phase(const Ctx& C) {
    LAS float* sf = (LAS float*)C.lds; LAS float* sk = sf + 8 * 128; LAS float* sq = sk + 8 * 128; LAS float* sv = sq + 8 * 128; LAS float* red = sv + 8 * 128;
    unsigned char* ws = C.ws; const int tid = C.tid;
    const h16* Q = (const h16*)(ws + WS_Q); const bf16_t* V = (const bf16_t*)(ws + WS_V);
    const h16* ZF = (const h16*)C.out; const h16* ZB = ZF + (size_t)M * D;
    const float* lbv = C.vec + VW_LB;
    const int kq = tid >> 7, vv = tid & 127;
    for (int item = C.vcu; item < (MK_SCAN_HYBRID ? 64 : 320); item += C.G) {
        int seq, h, dir;
        if (item < 64) { seq = 16 + item / 16; h = (item % 16) >> 1; dir = item & 1; } else { const int i2 = item - 64; seq = i2 / 16; h = (i2 % 16) >> 1; dir = i2 & 1; }
        const int L = seq < 16 ? 256 : 4096, row0 = seq < 16 ? seq * 256 : M_CTX + (seq - 16) * 4096;
        const h16* Z = dir ? ZB : ZF; h16* O = (h16*)(ws + (dir ? WS_AY : WS_AX));
        float S[32];
        if (seq < 16) {
#pragma unroll
            for (int i = 0; i < 32; ++i) S[i] = 0.f;
        } else { const float* s0 = C.in[2] + ((((size_t)(seq - 16) * 2 + dir) * NH + h) * HD) * HD;
#pragma unroll
            for (int i = 0; i < 32; ++i) S[i] = s0[(size_t)(kq * 32 + i) * HD + vv]; }
        for (int tb = 0; tb < L; tb += 8) {
            __syncthreads();
            if (tid < 128) { const float lb = lbv[dir * D + h * HD + tid];
#pragma unroll
                for (int j = 0; j < 8; ++j) { const int t = dir ? L - 1 - (tb + j) : tb + j; const size_t off = (size_t)(row0 + t) * D + h * HD + tid;
                    const float f = lb + (1.0f - lb) * sigmoidf_((float)Z[off]); sf[j * 128 + tid] = f; sk[j * 128 + tid] = 1.0f - f; sq[j * 128 + tid] = (float)Q[off]; }
            } else if (tid < 256) { const int c = tid - 128;
#pragma unroll
                for (int j = 0; j < 8; ++j) { const int t = dir ? L - 1 - (tb + j) : tb + j; sv[j * 128 + c] = bf2f(V[(size_t)(row0 + t) * D + h * HD + c]); }
            }
            __syncthreads();
#pragma unroll 1
            for (int j = 0; j < 8; ++j) { const float vval = sv[j * 128 + vv]; float part = 0.f;
#pragma unroll
                for (int i = 0; i < 32; ++i) { const int k = kq * 32 + i; S[i] = sf[j * 128 + k] * S[i] + sk[j * 128 + k] * vval; part += sq[j * 128 + k] * S[i]; }
                red[(kq * 8 + j) * 128 + vv] = part; }
            __syncthreads();
            if (tid < 128) {
#pragma unroll
                for (int j = 0; j < 8; ++j) { const int t = dir ? L - 1 - (tb + j) : tb + j;
                    const float o = (red[(0 * 8 + j) * 128 + tid] + red[(1 * 8 + j) * 128 + tid]) + (red[(2 * 8 + j) * 128 + tid] + red[(3 * 8 + j) * 128 + tid]);
                    if (!(MK_SCAN_DBG == 1 && seq < 16 && dir == 0) && !(MK_SCAN_DBG == 2 && seq < 16 && dir == 1)) O[(size_t)(row0 + t) * D + h * HD + tid] = (h16)o; }
            }
        }
        if (seq < 16 && MK_SCAN_DBG != 3) { float* so = C.out + (size_t)M * D + ((((size_t)seq * 2 + dir) * NH + h) * HD) * HD;
#pragma unroll
            for (int i = 0; i < 32; ++i) so[(size_t)(kq * 32 + i) * HD + vv] = S[i]; }
    }
    __syncthreads();
}
__device__ __forceinline__ void naive_combine_phase(const Ctx& C) {
    unsigned char* ws = C.ws; const int gw = C.vcu * NWAVES + C.wave, NGW = C.G * NWAVES, lane = C.lane;
    h16* AX = (h16*)(ws + WS_AX); const h16* AY = (const h16*)(ws + WS_AY); const h16* Gt = (const h16*)(ws + WS_G); const float* og = C.in[13];
    for (int task = gw + ((MK_SCAN_HYBRID || MK_SCAN_DBG == 4) ? M_CTX * NH : 0); task < M * NH; task += NGW) {
        const int row = task >> 3, h = task & 7; const size_t off = (size_t)row * D + h * HD + lane * 2;
        const h16x2 a = *(const h16x2*)(AX + off), b = *(const h16x2*)(AY + off), g = *(const h16x2*)(Gt + off);
        if (MK_SCAN_DBG == 5 && row < M_CTX) { *(unsigned*)(AX + off) = pk_h16((float)a.x * og[h * HD + lane * 2] * (float)g.x, (float)a.y * og[h * HD + lane * 2 + 1] * (float)g.y); continue; }
        const float o0 = (float)a.x + ((MK_SCAN_DBG == 6 && row < M_CTX) ? 0.f : (float)b.x), o1 = (float)a.y + ((MK_SCAN_DBG == 6 && row < M_CTX) ? 0.f : (float)b.y);
        const float r = rsqrtf(wave_sum(o0 * o0 + o1 * o1) * (1.0f / HD) + EPS);
        *(unsigned*)(AX + off) = pk_h16(o0 * r * og[h * HD + lane * 2] * (float)g.x, o1 * r * og[h * HD + lane * 2 + 1] * (float)g.y);
    }
}


namespace fs {
typedef __bf16 b16x8 __attribute__((ext_vector_type(8)));
constexpr int QS = 272, TS = 144, SS = 272;
constexpr int L_Q = 0, L_K = L_Q + 64 * QS, L_KT = L_K + 64 * QS, L_VT = L_KT + 128 * TS, L_P = L_VT + 128 * TS, L_ST = L_P + 64 * TS, L_EM = L_ST + 128 * SS, L_ET = L_EM + 512,
              L_SEG = L_ET + 512, L_RED = L_SEG + 4096, L_END = L_RED + 2048;
static_assert(L_END <= 131072, "scan LDS");
constexpr int NS = 8, TSUP = 512;
constexpr float TINY = 1e-30f;
constexpr size_t U_SLOT_FLOATS = 128 * 128, U_DT_OFF = (size_t)512 * U_SLOT_FLOATS;
__device__ __forceinline__ int uslot(int seql, int h, int dir, int j) { return ((seql * NH + h) * 2 + dir) * NS + j; }

struct Raw { unsigned q[8], z[8], v[8]; };
typedef __amdgpu_buffer_rsrc_t rsrc_t;
__device__ __forceinline__ rsrc_t mk_rsrc(const void* p, unsigned bytes) { return __builtin_amdgcn_make_buffer_rsrc((void*)p, 0, (int)bytes, 0x00020000); }
template <bool NEEDQ>
__device__ __forceinline__ void load_raw(Raw& r, rsrc_t rQ, rsrc_t rZ, rsrc_t rV, int cbase, int dir, int h, int sg, int lane) {
    const unsigned voff = (unsigned)lane * 4u;
#pragma unroll
    for (int j = 0; j < 8; ++j) { const int p = 8 * sg + j, row = dir ? cbase + 63 - p : cbase + p; const unsigned soff = (unsigned)(row * D + h * HD) * 2u;
        r.z[j] = __builtin_amdgcn_raw_buffer_load_b32(rZ, voff, soff, 0); r.v[j] = __builtin_amdgcn_raw_buffer_load_b32(rV, voff, soff, 0); if (NEEDQ) r.q[j] = __builtin_amdgcn_raw_buffer_load_b32(rQ, voff, soff, 0); }
}
__device__ __forceinline__ b16x8 ldf(LAS const unsigned char* p) { return *(const LAS b16x8*)p; }
#define FS_MFMA(a, b, c) __builtin_amdgcn_mfma_f32_16x16x32_bf16(a, b, c, 0, 0, 0)
#define FS_BAR() do { asm volatile("s_waitcnt lgkmcnt(0)" ::: "memory"); __builtin_amdgcn_s_barrier(); asm volatile("" ::: "memory"); } while (0)

__device__ __forceinline__ void state_update(LAS unsigned char* lds, f32x4 (&S)[8], int wave, int fr, int fq) {
#pragma unroll
    for (int kt = 0; kt < 8; ++kt) { const f32x4 et = *(const LAS f32x4*)(lds + L_ET + (16 * kt + 4 * fq) * 4); S[kt] = S[kt] * et; }
#pragma unroll
    for (int ks = 0; ks < 2; ++ks) { const b16x8 B = ldf(lds + L_VT + (16 * wave + fr) * TS + ks * 64 + fq * 16);
#pragma unroll
        for (int kt = 0; kt < 8; ++kt) { const b16x8 A = ldf(lds + L_KT + (16 * kt + fr) * TS + ks * 64 + fq * 16); S[kt] = FS_MFMA(A, B, S[kt]); } }
}
__device__ __forceinline__ void write_kt_vt(LAS unsigned char* lds, const float (&kh0)[8], const float (&kh1)[8], const Raw& raw, int sg, int lane) {
    u32x4 a, b; a.x = pk_bf16(kh0[0], kh0[1]); a.y = pk_bf16(kh0[2], kh0[3]); a.z = pk_bf16(kh0[4], kh0[5]); a.w = pk_bf16(kh0[6], kh0[7]);
    b.x = pk_bf16(kh1[0], kh1[1]); b.y = pk_bf16(kh1[2], kh1[3]); b.z = pk_bf16(kh1[4], kh1[5]); b.w = pk_bf16(kh1[6], kh1[7]);
    *(LAS u32x4*)(lds + L_KT + (2 * lane) * TS + sg * 16) = a; *(LAS u32x4*)(lds + L_KT + (2 * lane + 1) * TS + sg * 16) = b;
    u32x4 c, d;
    c.x = (raw.v[0] & 0xffffu) | (raw.v[1] << 16); c.y = (raw.v[2] & 0xffffu) | (raw.v[3] << 16); c.z = (raw.v[4] & 0xffffu) | (raw.v[5] << 16); c.w = (raw.v[6] & 0xffffu) | (raw.v[7] << 16);
    d.x = (raw.v[0] >> 16) | (raw.v[1] & 0xffff0000u); d.y = (raw.v[2] >> 16) | (raw.v[3] & 0xffff0000u); d.z = (raw.v[4] >> 16) | (raw.v[5] & 0xffff0000u); d.w = (raw.v[6] >> 16) | (raw.v[7] & 0xffff0000u);
    *(LAS u32x4*)(lds + L_VT + (2 * lane) * TS + sg * 16) = c; *(LAS u32x4*)(lds + L_VT + (2 * lane + 1) * TS + sg * 16) = d;
}

__device__ __forceinline__ void passA_item(const Ctx& C, int seql, int h, int dir, int j) {
    LAS unsigned char* lds = C.lds; const int wave = C.wave, lane = C.lane, fr = lane & 15, fq = lane >> 4, sg = wave;
    const rsrc_t rZ = mk_rsrc((const h16*)C.out + (dir ? (size_t)M * D : 0), ACT_BYTES), rV = mk_rsrc(C.ws + WS_V, ACT_BYTES);
    const float* lbv = C.vec + VW_LB; const float lb0 = lbv[dir * D + h * HD + 2 * lane], lb1 = lbv[dir * D + h * HD + 2 * lane + 1];
    const int base = M_CTX + seql * 4096 + j * TSUP, nc = TSUP / 64;
    f32x4 S[8];
#pragma unroll
    for (int kt = 0; kt < 8; ++kt) S[kt] = (f32x4){0.f, 0.f, 0.f, 0.f};
    float dt0 = 1.f, dt1 = 1.f;
    Raw raw; load_raw<false>(raw, rV, rZ, rV, dir ? base + TSUP - 64 : base, dir, h, sg, lane);
    for (int c = 0; c < nc; ++c) {
        float e0[8], e1[8];
        { float f0[8], f1[8];
#pragma unroll
          for (int jj = 0; jj < 8; ++jj) { const h16x2 hz = __builtin_bit_cast(h16x2, raw.z[jj]); f0[jj] = lb0 + (1.f - lb0) * sigmoidf_((float)hz.x); f1[jj] = lb1 + (1.f - lb1) * sigmoidf_((float)hz.y); }
          e0[7] = 1.f; e1[7] = 1.f;
#pragma unroll
          for (int jj = 6; jj >= 0; --jj) { e0[jj] = e0[jj + 1] * f0[jj + 1]; e1[jj] = e1[jj + 1] * f1[jj + 1]; }
          *(LAS f32x2*)(lds + L_SEG + (sg * 128 + 2 * lane) * 4) = (f32x2){e0[0] * f0[0], e1[0] * f1[0]};
#pragma unroll
          for (int jj = 0; jj < 8; ++jj) { e0[jj] *= (1.f - f0[jj]); e1[jj] *= (1.f - f1[jj]); }
        }
        FS_BAR();
        float o0 = 1.f, o1 = 1.f, t0 = 1.f, t1 = 1.f;
#pragma unroll
        for (int s2 = 0; s2 < 8; ++s2) { const f32x2 t = *(const LAS f32x2*)(lds + L_SEG + (s2 * 128 + 2 * lane) * 4); t0 *= t.x; t1 *= t.y; if (s2 > sg) { o0 *= t.x; o1 *= t.y; } }
#pragma unroll
        for (int jj = 0; jj < 8; ++jj) { e0[jj] *= o0; e1[jj] *= o1; }
        write_kt_vt(lds, e0, e1, raw, sg, lane);
        if (sg == 0) *(LAS f32x2*)(lds + L_ET + 2 * lane * 4) = (f32x2){t0, t1};
        dt0 *= t0; dt1 *= t1;
        FS_BAR();
        if (c + 1 < nc) load_raw<false>(raw, rV, rZ, rV, dir ? base + TSUP - 64 * (c + 2) : base + 64 * (c + 1), dir, h, sg, lane);
        state_update(lds, S, wave, fr, fq);
        FS_BAR();
    }
    { const rsrc_t rU = mk_rsrc(C.ws + WS_AY, ACT_BYTES); const unsigned vo = (unsigned)(wave * 64 + lane) * 16u, so = (unsigned)uslot(seql, h, dir, j) * 65536u;
#pragma unroll
      for (int kt = 0; kt < 8; ++kt) __builtin_amdgcn_raw_buffer_store_b128(__builtin_bit_cast(u32x4, S[kt]), rU, vo, so + kt * 8192u, 0); }
    if (sg == 0) { float* Dt = (float*)(C.ws + WS_AY) + U_DT_OFF + (size_t)uslot(seql, h, dir, j) * 128; *(f32x2*)(Dt + 2 * lane) = (f32x2){dt0, dt1}; }
}
__device__ __forceinline__ void passA_phase(const Ctx& C) {
    for (int it = C.vcu; it < 4 * NH * 2 * (NS - 1); it += C.G) {
        const int jj = it % (NS - 1), r = it / (NS - 1), dir = r & 1, h = (r >> 1) & 7, seql = r >> 4;
        passA_item(C, seql, h, dir, dir ? jj + 1 : jj);
    }
}

template <int DBG, int dir>
__device__ __forceinline__ void passC_dir(const Ctx& C, int seq, int h, int t0, int T, int jsup) {
    LAS unsigned char* lds = C.lds; const int wave = C.wave, lane = C.lane, fr = lane & 15, fq = lane >> 4, sg = wave;
    const rsrc_t rQ = mk_rsrc(C.ws + WS_Q, ACT_BYTES), rV = mk_rsrc(C.ws + WS_V, ACT_BYTES), rG = mk_rsrc(C.ws + WS_G, ACT_BYTES), rX = mk_rsrc(C.ws + (DBG == 2 ? WS_AY : WS_AX), ACT_BYTES), rU = mk_rsrc(C.ws + WS_AY, ACT_BYTES);
    const float* lbv = C.vec + VW_LB; const float* og = C.in[13] + h * HD;
    const int seqbase = seq < 16 ? seq * 256 : M_CTX + (seq - 16) * 4096, base = seqbase + t0, nc = T / 64;
    {
        const rsrc_t rZ = mk_rsrc((const h16*)C.out + (dir ? (size_t)M * D : 0), ACT_BYTES);
        const float lb0 = lbv[dir * D + h * HD + 2 * lane], lb1 = lbv[dir * D + h * HD + 2 * lane + 1];
        const unsigned voX = (unsigned)((dir ? 15 - fr : fr) * D + 16 * wave + 4 * fq) * 2u;
        Raw raw; load_raw<true>(raw, rQ, rZ, rV, dir ? base + T - 64 : base, dir, h, sg, lane);
        f32x4 S[8];
        if (seq < 16) {
#pragma unroll
            for (int kt = 0; kt < 8; ++kt) S[kt] = (f32x4){0.f, 0.f, 0.f, 0.f};
        } else {
            const int seql = seq - 16;
            const float* s0 = C.in[2] + ((((size_t)seql * 2 + dir) * NH + h) * HD) * HD;
#pragma unroll
            for (int kt = 0; kt < 8; ++kt) { const float* sp = s0 + (size_t)(16 * kt + 4 * fq) * HD + 16 * wave + fr; S[kt] = (f32x4){sp[0], sp[HD], sp[2 * HD], sp[3 * HD]}; }
            const int nchain = dir ? NS - 1 - jsup : jsup; const unsigned vo = (unsigned)(wave * 64 + lane) * 16u;
            for (int ii = 0; ii < nchain; ++ii) { const int i = dir ? NS - 1 - ii : ii; const unsigned sl = (unsigned)uslot(seql, h, dir, i);
#pragma unroll
                for (int kt = 0; kt < 8; ++kt) { const f32x4 u = __builtin_bit_cast(f32x4, __builtin_amdgcn_raw_buffer_load_b128(rU, vo, sl * 65536u + kt * 8192u, 0)),
                        d = __builtin_bit_cast(f32x4, __builtin_amdgcn_raw_buffer_load_b128(rU, (unsigned)fq * 16u, (unsigned)(U_DT_OFF * 4) + sl * 512u + kt * 64u, 0)); S[kt] = d * S[kt] + u; } }
        }
        for (int c = 0; c < nc; ++c) {
            const int cbase = dir ? base + T - 64 * (c + 1) : base + 64 * c;
            float e0[8], e1[8], k0[8], k1[8];
            { float f0[8], f1[8];
#pragma unroll
              for (int j = 0; j < 8; ++j) { const h16x2 hz = __builtin_bit_cast(h16x2, raw.z[j]); f0[j] = lb0 + (1.f - lb0) * sigmoidf_((float)hz.x); f1[j] = lb1 + (1.f - lb1) * sigmoidf_((float)hz.y); k0[j] = 1.f - f0[j]; k1[j] = 1.f - f1[j]; }
              float tot0, tot1;
              if (sg < 4) { e0[7] = 1.f; e1[7] = 1.f;
#pragma unroll
                  for (int j = 6; j >= 0; --j) { e0[j] = e0[j + 1] * f0[j + 1]; e1[j] = e1[j + 1] * f1[j + 1]; }
                  tot0 = e0[0] * f0[0]; tot1 = e1[0] * f1[0];
              } else { e0[0] = f0[0]; e1[0] = f1[0];
#pragma unroll
                  for (int j = 1; j < 8; ++j) { e0[j] = e0[j - 1] * f0[j]; e1[j] = e1[j - 1] * f1[j]; }
                  tot0 = e0[7]; tot1 = e1[7]; }
              *(LAS f32x2*)(lds + L_SEG + (sg * 128 + 2 * lane) * 4) = (f32x2){tot0, tot1};
            }
            FS_BAR();
            { float em0 = 1.f, em1 = 1.f, el0 = 1.f, el1 = 1.f, o0 = 1.f, o1 = 1.f;
#pragma unroll
              for (int s2 = 0; s2 < 8; ++s2) { const f32x2 t = *(const LAS f32x2*)(lds + L_SEG + (s2 * 128 + 2 * lane) * 4);
                  if (s2 < 4) { em0 *= t.x; em1 *= t.y; if (s2 > sg) { o0 *= t.x; o1 *= t.y; } } else { el0 *= t.x; el1 *= t.y; if (s2 < sg) { o0 *= t.x; o1 *= t.y; } } }
              float kh0[8], kh1[8];
#pragma unroll
              for (int j = 0; j < 8; ++j) { const h16x2 hq = __builtin_bit_cast(h16x2, raw.q[j]); const float q0 = (float)hq.x, q1 = (float)hq.y;
                  const float r0 = e0[j] * o0, r1 = e1[j] * o1; float qt0, qt1, kt0, kt1;
                  if (sg < 4) { qt0 = q0 * rcpf(fmaxf(r0, TINY)); qt1 = q1 * rcpf(fmaxf(r1, TINY)); kt0 = k0[j] * r0; kt1 = k1[j] * r1; }
                  else { qt0 = q0 * r0; qt1 = q1 * r1; kt0 = k0[j] * rcpf(fmaxf(r0, TINY)); kt1 = k1[j] * rcpf(fmaxf(r1, TINY)); }
                  kh0[j] = kt0 * el0; kh1[j] = kt1 * el1;
                  const int p = 8 * sg + j;
                  *(LAS unsigned*)(lds + L_Q + p * QS + lane * 4) = pk_bf16(qt0, qt1); *(LAS unsigned*)(lds + L_K + p * QS + lane * 4) = pk_bf16(kt0, kt1); }
              write_kt_vt(lds, kh0, kh1, raw, sg, lane);
              if (sg == 0) { *(LAS f32x2*)(lds + L_EM + 2 * lane * 4) = (f32x2){em0, em1}; *(LAS f32x2*)(lds + L_ET + 2 * lane * 4) = (f32x2){em0 * el0, em1 * el1}; }
            }
            FS_BAR();
            if (c + 1 < nc) load_raw<true>(raw, rQ, rZ, rV, dir ? base + T - 64 * (c + 2) : base + 64 * (c + 1), dir, h, sg, lane);
            __builtin_amdgcn_sched_barrier(0);
#pragma unroll
            for (int kt = 0; kt < 8; ++kt) { const f32x4 em = *(const LAS f32x4*)(lds + L_EM + (16 * kt + 4 * fq) * 4); const f32x4 sv = S[kt] * em;
                u32x2 w; w.x = pk_bf16(sv.x, sv.y); w.y = pk_bf16(sv.z, sv.w); *(LAS u32x2*)(lds + L_ST + (16 * wave + fr) * SS + (16 * kt + 4 * fq) * 2) = w; }
            __builtin_amdgcn_sched_barrier(0);
            { const int pt = wave >> 1;
#pragma unroll
              for (int e = 0; e < 2; ++e) { const int ppt = 2 * (wave & 1) + e; f32x4 a = (f32x4){0.f, 0.f, 0.f, 0.f};
#pragma unroll
                  for (int ks = 0; ks < 4; ++ks) { const b16x8 A = ldf(lds + L_K + (16 * ppt + fr) * QS + ks * 64 + fq * 16), B = ldf(lds + L_Q + (16 * pt + fr) * QS + ks * 64 + fq * 16); a = FS_MFMA(A, B, a); }
                  const int p = 16 * pt + fr, pp = 16 * ppt + 4 * fq;
                  a.x = (pp + 0 <= p) ? a.x : 0.f; a.y = (pp + 1 <= p) ? a.y : 0.f; a.z = (pp + 2 <= p) ? a.z : 0.f; a.w = (pp + 3 <= p) ? a.w : 0.f;
                  u32x2 w; w.x = pk_bf16(a.x, a.y); w.y = pk_bf16(a.z, a.w); *(LAS u32x2*)(lds + L_P + p * TS + pp * 2) = w; } }
            __builtin_amdgcn_sched_barrier(0);
            FS_BAR();
            f32x4 o[4];
#pragma unroll
            for (int pt = 0; pt < 4; ++pt) o[pt] = (f32x4){0.f, 0.f, 0.f, 0.f};
#pragma unroll
            for (int ks = 0; ks < 4; ++ks) { const b16x8 A = ldf(lds + L_ST + (16 * wave + fr) * SS + ks * 64 + fq * 16);
#pragma unroll
                for (int pt = 0; pt < 4; ++pt) { const b16x8 B = ldf(lds + L_Q + (16 * pt + fr) * QS + ks * 64 + fq * 16); o[pt] = FS_MFMA(A, B, o[pt]); } }
#pragma unroll
            for (int ks = 0; ks < 2; ++ks) { const b16x8 A = ldf(lds + L_VT + (16 * wave + fr) * TS + ks * 64 + fq * 16);
#pragma unroll
                for (int pt = 0; pt < 4; ++pt) { const b16x8 B = ldf(lds + L_P + (16 * pt + fr) * TS + ks * 64 + fq * 16); o[pt] = FS_MFMA(A, B, o[pt]); } }
            __builtin_amdgcn_sched_barrier(0);
            if (!dir || DBG == 2 || DBG == 3) {
                if (DBG != 3) {
#pragma unroll
                for (int pt = 0; pt < 4; ++pt) { u32x2 w; w.x = pk_h16(o[pt].x, o[pt].y); w.y = pk_h16(o[pt].z, o[pt].w);
                    __builtin_amdgcn_raw_buffer_store_b64(w, rX, voX, (unsigned)((cbase + (dir ? 48 - 16 * pt : 16 * pt)) * D + h * HD) * 2u, 0); }
                }
                state_update(lds, S, wave, fr, fq);
                FS_BAR();
            } else {
                h16x4 of[4], gg[4];
#pragma unroll
                for (int pt = 0; pt < 4; ++pt) { const unsigned so = (unsigned)((cbase + 48 - 16 * pt) * D + h * HD) * 2u;
                    of[pt] = __builtin_bit_cast(h16x4, __builtin_amdgcn_raw_buffer_load_b64(rX, voX, so, 0)); gg[pt] = __builtin_bit_cast(h16x4, __builtin_amdgcn_raw_buffer_load_b64(rG, voX, so, 0)); }
#pragma unroll
                for (int pt = 0; pt < 4; ++pt) {
                    o[pt].x += (float)of[pt].x; o[pt].y += (float)of[pt].y; o[pt].z += (float)of[pt].z; o[pt].w += (float)of[pt].w;
                    float ss = (o[pt].x * o[pt].x + o[pt].y * o[pt].y) + (o[pt].z * o[pt].z + o[pt].w * o[pt].w);
                    ss += __shfl_xor(ss, 16); ss += __shfl_xor(ss, 32);
                    if (fq == 0) *(LAS float*)(lds + L_RED + (wave * 64 + 16 * pt + fr) * 4) = ss; }
                state_update(lds, S, wave, fr, fq);
                FS_BAR();
                const f32x4 ogv = *(const f32x4*)(og + 16 * wave + 4 * fq);
#pragma unroll
                for (int pt = 0; pt < 4; ++pt) { const int p = 16 * pt + fr; float ss = 0.f;
#pragma unroll
                    for (int w2 = 0; w2 < 8; ++w2) ss += *(const LAS float*)(lds + L_RED + (w2 * 64 + p) * 4);
                    const float rs = rsqrtf(ss * (1.0f / HD) + EPS);
                    f32x4 r; r.x = o[pt].x * rs * ogv.x * (float)gg[pt].x; r.y = o[pt].y * rs * ogv.y * (float)gg[pt].y; r.z = o[pt].z * rs * ogv.z * (float)gg[pt].z; r.w = o[pt].w * rs * ogv.w * (float)gg[pt].w;
                    if (DBG == 5) { r.x = o[pt].x * rs; r.y = o[pt].y * rs; r.z = o[pt].z * rs; r.w = o[pt].w * rs; }
                    if (DBG == 6) { r = o[pt]; }
                    u32x2 w; w.x = pk_h16(r.x, r.y); w.y = pk_h16(r.z, r.w);
                    __builtin_amdgcn_raw_buffer_store_b64(w, rX, voX, (unsigned)((cbase + 48 - 16 * pt) * D + h * HD) * 2u, 0); }
                FS_BAR();
            }
        }
        if (seq < 16 && (DBG == 0 || DBG == 3)) { float* so = C.out + (size_t)M * D + ((((size_t)seq * 2 + dir) * NH + h) * HD) * HD;
#pragma unroll
            for (int kt = 0; kt < 8; ++kt) { float* sp = so + (size_t)(16 * kt + 4 * fq) * HD + 16 * wave + fr; sp[0] = S[kt].x; sp[HD] = S[kt].y; sp[2 * HD] = S[kt].z; sp[3 * HD] = S[kt].w; } }
        asm volatile("s_waitcnt vmcnt(0)" ::: "memory");
        __syncthreads();
    }
}
template <int DBG>
__device__ __forceinline__ void passC_item(const Ctx& C, int seq, int h, int t0, int T, int jsup) {
    if (DBG != 2 && DBG < 4) passC_dir<DBG, 0>(C, seq, h, t0, T, jsup);
    if (DBG != 1) passC_dir<DBG, 1>(C, seq, h, t0, T, jsup);
}
__device__ __forceinline__ void passC_phase(const Ctx& C) {
    for (int it = C.vcu; it < 256 + 128; it += C.G) {
        if (it < 256) passC_item<0>(C, 16 + (it >> 6), (it >> 3) & 7, (it & 7) * TSUP, TSUP, it & 7);
        else { const int i2 = it - 256; passC_item<0>(C, i2 >> 3, i2 & 7, 0, 256, 0); }
    }
}
#undef FS_MFMA
#undef FS_BAR
}

__device__ __forceinline__ void naive_spatial_phase(const Ctx& C) {
    LAS float* As = (LAS float*)C.lds; LAS float* Bs = As + 16 * 132;
    unsigned char* ws = C.ws; const int tid = C.tid, ty = tid >> 5, tx = tid & 31;
    const h16* U = (const h16*)(ws + WS_U); const h16* V2 = (const h16*)(ws + WS_V2); const h16* Wsp = (const h16*)(ws + WS_W_WS); h16* AX = (h16*)(ws + WS_AX);
    const float* vs1 = C.ctlf + CW_VS1; const float* vs2 = C.ctlf + CW_VS2; const float* lng = C.in[16]; const float* lnb = C.in[17]; const float* bs = C.in[19];
    for (int item = C.vcu; item < (M / 128) * 8; item += C.G) {
        const int ch = item >> 3, g = item & 7, r0 = ch * 128;
        f32x4 acc[8];
#pragma unroll
        for (int i = 0; i < 8; ++i) acc[i] = (f32x4){0.f, 0.f, 0.f, 0.f};
        const int r = tid >> 2, kk = (tid & 3) * 4;
        for (int k0 = 0; k0 < 128; k0 += 16) {
            const h16x4 a = *(const h16x4*)(Wsp + ((size_t)g * 128 + r) * 128 + k0 + kk);
            const int qq = tid >> 5, c4 = (tid & 31) * 4, qrow = r0 + k0 + qq;
            const h16x4 vr = *(const h16x4*)(V2 + (size_t)qrow * D + g * 128 + c4);
            const float mu = vs1[qrow] * (1.0f / D), var = vs2[qrow] * (1.0f / D) - mu * mu, rs = rsqrtf(var + EPS);
            const f32x4 lg = *(const f32x4*)(lng + g * 128 + c4), lb = *(const f32x4*)(lnb + g * 128 + c4);
            f32x4 vn; vn.x = ((float)vr.x - mu) * rs * lg.x + lb.x; vn.y = ((float)vr.y - mu) * rs * lg.y + lb.y; vn.z = ((float)vr.z - mu) * rs * lg.z + lb.z; vn.w = ((float)vr.w - mu) * rs * lg.w + lb.w;
            __syncthreads();
#pragma unroll
            for (int j = 0; j < 4; ++j) As[(kk + j) * 132 + r] = (float)a[j];
            *(LAS f32x4*)(Bs + qq * 132 + c4) = vn;
            __syncthreads();
#pragma unroll 2
            for (int k = 0; k < 16; ++k) {
                const f32x4 a0 = *(LAS f32x4*)(As + k * 132 + ty * 8), a1 = *(LAS f32x4*)(As + k * 132 + ty * 8 + 4), bv = *(LAS f32x4*)(Bs + k * 132 + tx * 4);
                acc[0] += a0.x * bv; acc[1] += a0.y * bv; acc[2] += a0.z * bv; acc[3] += a0.w * bv;
                acc[4] += a1.x * bv; acc[5] += a1.y * bv; acc[6] += a1.z * bv; acc[7] += a1.w * bv;
            }
        }
#pragma unroll
        for (int i = 0; i < 8; ++i) { const int p = ty * 8 + i; const size_t off = (size_t)(r0 + p) * D + g * 128 + tx * 4;
            const h16x4 u = *(const h16x4*)(U + off); const float b = bs[g * 128 + p];
            f32x4 o; o.x = (float)u.x * (acc[i].x + b); o.y = (float)u.y * (acc[i].y + b); o.z = (float)u.z * (acc[i].z + b); o.w = (float)u.w * (acc[i].w + b);
            st_h16x4(AX + off, o); }
    }
    __syncthreads();
}

__device__ __forceinline__ void final_norm_phase(const Ctx& C) {
    const int gw = C.vcu * NWAVES + C.wave, NGW = C.G * NWAVES, lane = C.lane;
    const float* rsq = C.ctlf + CW_RSQ_D; const float* g = C.in[21];
    for (int row = gw; row < M; row += NGW) {
        const float rstd = rsqrtf(rsq[row] * (1.0f / D) + EPS); float* xr = C.out + (size_t)row * D;
#pragma unroll
        for (int j = 0; j < 4; ++j) { const int col = j * 256 + lane * 4; const f32x4 v = *(const f32x4*)(xr + col), gg = *(const f32x4*)(g + col); *(f32x4*)(xr + col) = v * rstd * gg; }
    }
}


#define XB_TMO      128
#define XB_XCNT(j)  (256  + 64 * (j))
#define XB_XSUB(j)  (1280 + 64 * (j))
#define XB_XGEN(j)  (2304 + 64 * (j))
#define XB_TOP      3328
#define XB_TOPGEN   3392
#define XCD_BAR_WORDS 3456
#define XB_SPIN_CAP (1u << 20)
__device__ __forceinline__ unsigned xb_ld(unsigned* p)              { return __hip_atomic_load(p, __ATOMIC_RELAXED, __HIP_MEMORY_SCOPE_AGENT); }
__device__ __forceinline__ unsigned xb_add(unsigned* p, unsigned v) { return __hip_atomic_fetch_add(p, v, __ATOMIC_RELAXED, __HIP_MEMORY_SCOPE_AGENT); }
__device__ __forceinline__ unsigned xb_xcc_id() { return (unsigned)__builtin_amdgcn_s_getreg((3 << 11) | 20) & 0xFu; }
#define XB_SPIN(cond, bar) do { unsigned _sp = 0; while (cond) { __builtin_amdgcn_s_sleep(1); \
    if ((++_sp & 255u) == 0u) { if (xb_ld(&(bar)[XB_TMO])) break; if (_sp > XB_SPIN_CAP) { atomicAdd(&(bar)[XB_TMO], 1u); break; } } } } while (0)
struct XcdBarrier { unsigned* bar; unsigned x; volatile LAS unsigned* st; };
__device__ __forceinline__ XcdBarrier xcd_barrier_post(unsigned* bar, volatile LAS unsigned* st) {
    XcdBarrier b; b.bar = bar; b.x = xb_xcc_id(); b.st = st;
    if (threadIdx.x == 0) (void)xb_add(&bar[XB_XCNT(b.x)], 1u);
    return b;
}
__device__ __forceinline__ void xcd_barrier_complete(unsigned* bar, unsigned x, unsigned& nloc, unsigned& nx) {
    const unsigned G = gridDim.x * gridDim.y * gridDim.z;
    unsigned sum, cnt, mine, sp = 0u;
    for (;;) {
        sum = 0u; cnt = 0u; mine = 0u;
#pragma unroll
        for (unsigned j = 0; j < 16; ++j) { const unsigned c = xb_ld(&bar[XB_XCNT(j)]); sum += c; cnt += (c > 0u) ? 1u : 0u; mine = (j == x) ? c : mine; }
        if (sum == G) break;
        __builtin_amdgcn_s_sleep(1);
        if ((++sp & 255u) == 0u) { if (xb_ld(&bar[XB_TMO])) break; if (sp > XB_SPIN_CAP) { atomicAdd(&bar[XB_TMO], 1u); break; } }
    }
    nloc = mine > 0u ? mine : 1u; nx = cnt > 0u ? cnt : 1u;
}
__device__ __forceinline__ void xcd_barrier(const XcdBarrier& b) {
    asm volatile("s_waitcnt vmcnt(0)" ::: "memory");
    __syncthreads();
    if (threadIdx.x == 0) {
        unsigned* bar = b.bar;
        __builtin_amdgcn_s_waitcnt(0);
        unsigned nloc = b.st[0], nx = b.st[1];
        if (nloc == 0u) { xcd_barrier_complete(bar, b.x, nloc, nx); b.st[0] = nloc; b.st[1] = nx; }
        const unsigned old = xb_add(&bar[XB_XSUB(b.x)], 1u);
        const unsigned gen = old / nloc;
        if (old + 1u == (gen + 1u) * nloc) {
            __builtin_amdgcn_fence(__ATOMIC_RELEASE, "agent");
            asm volatile("s_waitcnt vmcnt(0)" ::: "memory");
            const unsigned og = xb_add(&bar[XB_TOP], 1u);
            const unsigned tg = og / nx;
            if (og + 1u == (tg + 1u) * nx) xb_add(&bar[XB_TOPGEN], 1u);
            else XB_SPIN(xb_ld(&bar[XB_TOPGEN]) == tg, bar);
            __builtin_amdgcn_fence(__ATOMIC_ACQUIRE, "agent");
            xb_add(&bar[XB_XGEN(b.x)], 1u);
            asm volatile("s_waitcnt vmcnt(0)" ::: "memory");
        } else {
            XB_SPIN(xb_ld(&bar[XB_XGEN(b.x)]) == gen, bar);
            __builtin_amdgcn_fence(__ATOMIC_ACQUIRE, "agent");
            asm volatile("s_waitcnt vmcnt(0)" ::: "memory");
        }
    }
    __syncthreads();
}

__global__ void __launch_bounds__(NTHREADS, 2) fwd_kernel(Args args) {
    extern __shared__ __attribute__((aligned(16))) unsigned char lds_raw[];
    Ctx C;
    C.lds = (LAS unsigned char*)lds_raw;
    C.tid = threadIdx.x; C.lane = C.tid & 63; C.wave = __builtin_amdgcn_readfirstlane(C.tid >> 6);
    C.G = gridDim.x; { const int bx = blockIdx.x; C.vcu = (C.G % 8 == 0) ? (bx % 8) * (C.G / 8) + bx / 8 : bx; }
    C.in = args.in; C.out = args.out; C.ws = args.ws;
    C.ctlf = (float*)(args.ws + WS_CTL); C.vec = (float*)(args.ws + WS_VEC);
    unsigned char* ws = args.ws;
    const int lo = args.ph_lo, hi = args.ph_hi;
    float* mod = C.ctlf + CW_MOD;
    h16* AX = (h16*)(ws + WS_AX); h16* AY = (h16*)(ws + WS_AY); h16* HID = (h16*)(ws + WS_HID);
    volatile LAS unsigned* MISC = (volatile LAS unsigned*)(C.lds + MISC_OFF);
    if (C.tid < 32) MISC[C.tid] = 0u;
    __syncthreads();
    XcdBarrier bar = xcd_barrier_post((unsigned*)C.ctlf + CW_BAR, MISC + 8);
#if MK_FAST_GEMM
#define GEMM_PHASE(PERM, A, W, Mr, N, K, E) fast_gemm_phase<decltype(E), PERM>(C, A, W, Mr, N, K, E)
#else
#define GEMM_PHASE(PERM, A, W, Mr, N, K, E) naive_gemm_phase(C, A, W, Mr, N, K, E)
#endif
#define IN(k) (lo <= (k) && (k) < hi)
#define SEAM(k) do { if (IN(k) && IN((k) + 1)) xcd_barrier(bar); } while (0)
    if (IN(0)) { phase0(C); SEAM(0); }
    if (IN(1)) { phase1(C); SEAM(1); }
    if (IN(2)) { EpiWin E{(h16*)(ws + WS_Q), (h16*)C.out, (h16*)C.out + (size_t)M * D, (bf16_t*)(ws + WS_V), (h16*)(ws + WS_G)};
        GEMM_PHASE(true, AX, (const h16*)(ws + WS_W_HIN), M, N_HIN, D, E); SEAM(2); }
#if MK_SCAN_DBG
    if (IN(3)) { naive_scan_phase(C); SEAM(3); }
    if (IN(4)) { for (int it = C.vcu; it < 128; it += C.G) fs::passC_item<MK_SCAN_DBG>(C, it >> 3, it & 7, 0, 256, 0); xcd_barrier(bar); naive_combine_phase(C); SEAM(4); }
#elif MK_SCAN_HYBRID
    if (IN(3)) { naive_scan_phase(C); SEAM(3); }
    if (IN(4)) { naive_combine_phase(C); for (int it = C.vcu; it < 128; it += C.G) fs::passC_item<0>(C, it >> 3, it & 7, 0, 256, 0); SEAM(4); }
#elif MK_FAST_SCAN
    if (IN(3)) { fs::passA_phase(C); SEAM(3); }
    if (IN(4)) { fs::passC_phase(C); SEAM(4); }
#else
    if (IN(3)) { naive_scan_phase(C); SEAM(3); }
    if (IN(4)) { naive_combine_phase(C); SEAM(4); }
#endif
    if (IN(5)) { EpiRes E{C.in[0], C.in[1], C.out, mod + 2 * D, C.vec + VW_GN, AY, C.ctlf + CW_RSQ_A};
        GEMM_PHASE(false, AX, (const h16*)(ws + WS_W_HOUT), M, D, D, E); SEAM(5); }
    if (IN(6)) { EpiHid E{C.ctlf + CW_RSQ_A, C.vec + VW_BMLP, HID};
        GEMM_PHASE(true, AY, (const h16*)(ws + WS_W_W1), M, FF, D, E); SEAM(6); }
    if (IN(7)) { EpiRes E{nullptr, nullptr, C.out, mod + 5 * D, C.vec + VW_GN + NCOND * D, AY, C.ctlf + CW_RSQ_B};
        GEMM_PHASE(false, HID, (const h16*)(ws + WS_W_W2), M, D, FF, E); SEAM(7); }
    if (IN(8)) { EpiCin E{C.ctlf + CW_RSQ_B, C.vec + VW_BCM, (h16*)(ws + WS_U), (h16*)(ws + WS_V2), C.ctlf + CW_VS1, C.ctlf + CW_VS2};
        GEMM_PHASE(true, AY, (const h16*)(ws + WS_W_CIN), M, N_CIN, D, E); SEAM(8); }
    if (IN(9)) { naive_spatial_phase(C); SEAM(9); }
    if (IN(10)) { EpiRes E{nullptr, nullptr, C.out, mod + (size_t)NCOND * 6 * D + 2 * D, C.vec + VW_GN + 2 * NCOND * D, AY, C.ctlf + CW_RSQ_C};
        GEMM_PHASE(false, AX, (const h16*)(ws + WS_W_COUT), M, D, D, E); SEAM(10); }
    if (IN(11)) { EpiHid E{C.ctlf + CW_RSQ_C, C.vec + VW_BMLP + NCOND * FF, HID};
        GEMM_PHASE(true, AY, (const h16*)(ws + WS_W_W1 + 8 * MiB), M, FF, D, E); SEAM(11); }
    if (IN(12)) { EpiRes E{nullptr, nullptr, C.out, mod + (size_t)NCOND * 6 * D + 5 * D, nullptr, nullptr, C.ctlf + CW_RSQ_D};
        GEMM_PHASE(false, HID, (const h16*)(ws + WS_W_W2 + 8 * MiB), M, D, FF, E); SEAM(12); }
    if (IN(13)) { final_norm_phase(C); }
#undef IN
#undef SEAM
}


extern "C" void kernel_launch(void* const* d_in, const int* in_sizes, int n_in, void* d_out, int out_size, void* d_ws, size_t ws_size, hipStream_t stream) {
    static int grid = 0;
    if (grid == 0) {
        if (n_in != 22 || ws_size < WS_END) { fprintf(stderr, "kernel_launch: unexpected shapes (n_in %d, ws %zu)\n", n_in, ws_size); grid = -1; return; }
        int dev = 0, cus = 0;
        if (hipGetDevice(&dev) != hipSuccess || hipDeviceGetAttribute(&cus, hipDeviceAttributeMultiprocessorCount, dev) != hipSuccess) { grid = -1; return; }
        if (hipFuncSetAttribute((const void*)fwd_kernel, hipFuncAttributeMaxDynamicSharedMemorySize, LDS_BYTES) != hipSuccess) { fprintf(stderr, "kernel_launch: hipFuncSetAttribute failed\n"); grid = -1; return; }
        grid = cus;
    }
    if (grid < 0) return;
    (void)hipMemsetAsync((char*)d_ws + WS_CTL, 0, CTL_ZERO_BYTES, stream);
    Args a{};
    for (int i = 0; i < 22; ++i) a.in[i] = (const float*)d_in[i];
    a.out = (float*)d_out; a.ws = (unsigned char*)d_ws;
#if MK_LAUNCH_PER_PHASE
    for (int p = 0; p < NPHASES; ++p) { a.ph_lo = p; a.ph_hi = p + 1; hipLaunchKernelGGL(fwd_kernel, dim3(grid), dim3(NTHREADS), LDS_BYTES, stream, a); }
#else
    a.ph_lo = 0; a.ph_hi = NPHASES; hipLaunchKernelGGL(fwd_kernel, dim3(grid), dim3(NTHREADS), LDS_BYTES, stream, a);
#endif
}
```

```cpp
#include <hip/hip_runtime.h>
#include <cstdio>
#include <cstdint>

#ifndef MK_FAST_GEMM
#define MK_FAST_GEMM 1
#endif
#ifndef MK_FAST_SPATIAL
#define MK_FAST_SPATIAL 1
#endif
#ifndef MK_SCAN_HYBRID
#define MK_SCAN_HYBRID 0
#endif
#ifndef MK_SCAN_DBG
#define MK_SCAN_DBG 0
#endif
#ifndef MK_FAST_SCAN
#define MK_FAST_SCAN 1
#endif
#ifndef MK_LAUNCH_PER_PHASE
#define MK_LAUNCH_PER_PHASE 0
#endif

#define GAS __attribute__((address_space(1)))
#define LAS __attribute__((address_space(3)))
typedef _Float16 h16;
typedef _Float16 h16x2 __attribute__((ext_vector_type(2)));
typedef _Float16 h16x4 __attribute__((ext_vector_type(4)));
typedef _Float16 h16x8 __attribute__((ext_vector_type(8)));
typedef float f32x2 __attribute__((ext_vector_type(2)));
typedef float f32x4 __attribute__((ext_vector_type(4)));
typedef unsigned u32x2 __attribute__((ext_vector_type(2)));
typedef unsigned u32x4 __attribute__((ext_vector_type(4)));
typedef unsigned short bf16_t;
typedef __bf16 bf16x2_t __attribute__((ext_vector_type(2)));

constexpr int D = 1024, M_CTX = 4096, M_LAT = 16384, M = M_CTX + M_LAT, FF = 4096, NCOND = 5, NH = 8, HD = 128;
constexpr int N_HIN = 5 * D, N_CIN = 2 * D;
constexpr float EPS = 1e-6f;
constexpr int NWAVES = 8, NTHREADS = 512, NPHASES = 14;
constexpr int LDS_BYTES = 147456, MISC_OFF = 131072 + 320;

constexpr size_t MiB = 1u << 20;
constexpr size_t WS_CTL = 0, CTL_ZERO_BYTES = 1 * MiB;
constexpr int CW_TMO = 0, CW_BAR = 1024, CW_MOD = 8192, CW_RSQ_A = CW_MOD + 2 * NCOND * 6 * D, CW_RSQ_B = CW_RSQ_A + M, CW_RSQ_C = CW_RSQ_B + M,
              CW_RSQ_D = CW_RSQ_C + M, CW_VS1 = CW_RSQ_D + M, CW_VS2 = CW_VS1 + M, CW_END = CW_VS2 + M;
static_assert((size_t)CW_END * 4 <= CTL_ZERO_BYTES, "ctl words");
constexpr size_t WS_VEC = 1 * MiB;
constexpr int VW_GN = 0  , VW_BMLP = VW_GN + 3 * NCOND * D  , VW_BCM = VW_BMLP + 2 * NCOND * FF  , VW_LB = VW_BCM + NCOND * N_CIN  , VW_END = VW_LB + 2 * D;
static_assert((size_t)VW_END * 4 <= MiB, "vec words");
constexpr size_t WS_W_HIN = 2 * MiB, WS_W_HOUT = 12 * MiB, WS_W_CIN = 14 * MiB, WS_W_COUT = 18 * MiB, WS_W_W1 = 20 * MiB  , WS_W_W2 = 36 * MiB  , WS_W_WS = 52 * MiB;
constexpr size_t WS_AY = 54 * MiB, WS_AX = 94 * MiB, WS_Q = 134 * MiB, WS_V = 174 * MiB, WS_G = 214 * MiB, WS_END = 254 * MiB;
constexpr size_t WS_HID = WS_AX;
constexpr size_t WS_U = WS_Q, WS_V2 = WS_V;
constexpr size_t ACT_BYTES = (size_t)M * D * 2;
static_assert(ACT_BYTES == 40 * MiB && WS_HID + (size_t)M * FF * 2 == WS_END, "map");

__device__ __forceinline__ float ex2(float x) { return __builtin_amdgcn_exp2f(x); }
__device__ __forceinline__ float rcpf(float x) { return __builtin_amdgcn_rcpf(x); }
__device__ __forceinline__ float sigmoidf_(float x) { return rcpf(1.0f + ex2(-1.4426950408889634f * x)); }
__device__ __forceinline__ float siluf_(float x) { return x * sigmoidf_(x); }
__device__ __forceinline__ float gelu_tanh(float x) { const float y = 0.7978845608028654f * (x + 0.044715f * x * x * x); const float t = 1.0f - 2.0f * rcpf(1.0f + ex2(2.885390081777927f * y)); return 0.5f * x * (1.0f + t); }
__device__ __forceinline__ float bf2f(bf16_t b) { return __uint_as_float((unsigned)b << 16); }
__device__ __forceinline__ unsigned pk_bf16(float lo, float hi) { f32x2 v = {lo, hi}; bf16x2_t b = __builtin_convertvector(v, bf16x2_t); return __builtin_bit_cast(unsigned, b); }
__device__ __forceinline__ unsigned pk_h16(float lo, float hi) { f32x2 v = {lo, hi}; h16x2 b = __builtin_convertvector(v, h16x2); return __builtin_bit_cast(unsigned, b); }
__device__ __forceinline__ void st_h16x4(h16* p, f32x4 v) { u32x2 w; w.x = pk_h16(v.x, v.y); w.y = pk_h16(v.z, v.w); *(u32x2*)p = w; }
__device__ __forceinline__ void st_bf16x4(bf16_t* p, f32x4 v) { u32x2 w; w.x = pk_bf16(v.x, v.y); w.y = pk_bf16(v.z, v.w); *(u32x2*)p = w; }
__device__ __forceinline__ float wave_sum(float v) {
#pragma unroll
    for (int o = 1; o < 64; o <<= 1) v += __shfl_xor(v, o);
    return v;
}
__device__ __forceinline__ int cond_of_row(int row) { return row < M_CTX ? 0 : 1 + ((row - M_CTX) >> 12); }

struct Args { const float* in[22]; float* out; unsigned char* ws; int ph_lo, ph_hi; };

struct Ctx {
    LAS unsigned char* lds;
    int tid, lane, wave, vcu, G;
    const float* const* in; float* out; unsigned char* ws;
    float* ctlf; float* vec;
};

struct EpiWin {
    static constexpr bool STATS = false;
    h16* Q; h16* ZF; h16* ZB; bf16_t* V; h16* Gt;
    __device__ __forceinline__ void apply(int row, int col, f32x4 a, float&, float&) const {
        const int grp = col >> 10, cc = col & 1023; const size_t off = (size_t)row * D + cc;
        if (grp == 0) { f32x4 s = {siluf_(a.x), siluf_(a.y), siluf_(a.z), siluf_(a.w)}; st_h16x4(Q + off, s); }
        else if (grp == 1) st_h16x4(ZF + off, a);
        else if (grp == 2) st_h16x4(ZB + off, a);
        else if (grp == 3) st_bf16x4(V + off, a);
        else { f32x4 s = {siluf_(a.x), siluf_(a.y), siluf_(a.z), siluf_(a.w)}; st_h16x4(Gt + off, s); }
    }
    __device__ __forceinline__ void commit(int, int, float, float) const {}
};
struct EpiRes {
    static constexpr bool STATS = true;
    const float* xp; const float* xs;
    float* out; const float* gate;
    const float* gn; h16* Aout;
    float* rsq;
    __device__ __forceinline__ void apply(int row, int col, f32x4 a, float&, float& s2) const {
        const int cond = cond_of_row(row); const size_t off = (size_t)row * D + col;
        const float* xo = xp ? (row < M_CTX ? xp + off : xs + (off - (size_t)M_CTX * D)) : out + off;
        const f32x4 x0 = *(const f32x4*)xo, g = *(const f32x4*)(gate + cond * 6 * D + col);
        const f32x4 xn = x0 + g * a;
        *(f32x4*)(out + off) = xn;
        s2 += (xn.x * xn.x + xn.y * xn.y) + (xn.z * xn.z + xn.w * xn.w);
        if (Aout) { const f32x4 gv = *(const f32x4*)(gn + cond * D + col); st_h16x4(Aout + off, xn * gv); }
    }
    __device__ __forceinline__ void commit(int row, int, float, float s2) const { atomicAdd(rsq + row, s2); }
};
struct EpiHid {
    static constexpr bool STATS = false;
    const float* rsq; const float* bias; h16* H;
    __device__ __forceinline__ void apply(int row, int col, f32x4 a, float&, float&) const {
        const int cond = cond_of_row(row); const float rstd = rsqrtf(rsq[row] * (1.0f / D) + EPS);
        const f32x4 b = *(const f32x4*)(bias + cond * FF + col);
        f32x4 z = a * rstd + b; z.x = fmaxf(z.x, 0.f); z.y = fmaxf(z.y, 0.f); z.z = fmaxf(z.z, 0.f); z.w = fmaxf(z.w, 0.f);
        st_h16x4(H + (size_t)row * FF + col, z * z);
    }
    __device__ __forceinline__ void commit(int, int, float, float) const {}
};
struct EpiCin {
    static constexpr bool STATS = true;
    const float* rsq; const float* bias; h16* U; h16* V2; float* vs1; float* vs2;
    __device__ __forceinline__ void apply(int row, int col, f32x4 a, float& s1, float& s2) const {
        const int cond = cond_of_row(row); const float rstd = rsqrtf(rsq[row] * (1.0f / D) + EPS);
        const f32x4 b = *(const f32x4*)(bias + cond * N_CIN + col);
        f32x4 z = a * rstd + b; z.x = gelu_tanh(z.x); z.y = gelu_tanh(z.y); z.z = gelu_tanh(z.z); z.w = gelu_tanh(z.w);
        if (col < D) st_h16x4(U + (size_t)row * D + col, z);
        else { st_h16x4(V2 + (size_t)row * D + (col - D), z); s1 += (z.x + z.y) + (z.z + z.w); s2 += (z.x * z.x + z.y * z.y) + (z.z * z.z + z.w * z.w); }
    }
    __device__ __forceinline__ void commit(int row, int col, float s1, float s2) const { if (col >= D) { atomicAdd(vs1 + row, s1); atomicAdd(vs2 + row, s2); } }
};

template <class Epi>
__device__ __forceinline__ void naive_gemm_phase(const Ctx& C, const h16* A, const h16* Wt, int Mr, int N, int K, const Epi& E) {
    LAS float* As = (LAS float*)C.lds; LAS float* Bs = As + 16 * 132;
    const int tid = C.tid, ty = tid >> 5, tx = tid & 31;
    const int ntn = N / 128, ntiles = (Mr / 128) * ntn;
    for (int t = C.vcu; t < ntiles; t += C.G) {
        const int pm = t / ntn, pn = t % ntn;
        f32x4 acc[8];
#pragma unroll
        for (int i = 0; i < 8; ++i) acc[i] = (f32x4){0.f, 0.f, 0.f, 0.f};
        const int r = tid >> 2, kk = (tid & 3) * 4;
        const h16* ap = A + (size_t)(pm * 128 + r) * K + kk; const h16* bp = Wt + (size_t)(pn * 128 + r) * K + kk;
        for (int k0 = 0; k0 < K; k0 += 16) {
            const h16x4 a = *(const h16x4*)(ap + k0), b = *(const h16x4*)(bp + k0);
            __syncthreads();
#pragma unroll
            for (int j = 0; j < 4; ++j) { As[(kk + j) * 132 + r] = (float)a[j]; Bs[(kk + j) * 132 + r] = (float)b[j]; }
            __syncthreads();
#pragma unroll 2
            for (int k = 0; k < 16; ++k) {
                const f32x4 a0 = *(LAS f32x4*)(As + k * 132 + ty * 8), a1 = *(LAS f32x4*)(As + k * 132 + ty * 8 + 4), bv = *(LAS f32x4*)(Bs + k * 132 + tx * 4);
                acc[0] += a0.x * bv; acc[1] += a0.y * bv; acc[2] += a0.z * bv; acc[3] += a0.w * bv;
                acc[4] += a1.x * bv; acc[5] += a1.y * bv; acc[6] += a1.z * bv; acc[7] += a1.w * bv;
            }
        }
#pragma unroll
        for (int i = 0; i < 8; ++i) { float s1 = 0.f, s2 = 0.f; const int row = pm * 128 + ty * 8 + i, col = pn * 128 + tx * 4; E.apply(row, col, acc[i], s1, s2); E.commit(row, col, s1, s2); }
    }
    __syncthreads();
}


namespace pg8 {
constexpr int BM = 256, BK = 64, HALF = 128, HTB = HALF * BK * 2, STAGE_BYTES = 8 * HTB, NXCD = 8, WGM = 8;
__host__ __device__ __forceinline__ int lds_byte(int r, int c) { const int st = (r >> 4) * 2 + (c >> 5), rr = r & 15, cc = c & 31, ob = rr * 64 + cc * 2; return st * 1024 + (ob ^ (((ob >> 9) & 1) << 5)); }
__host__ __device__ __forceinline__ void stage_rc(int b, int& R, int& C) { const int st = b / 1024, sb = b % 1024, swz = sb ^ (((sb >> 9) & 1) << 5); R = (st >> 1) * 16 + swz / 64; C = (st & 1) * 32 + (swz % 64) / 2; }
__host__ __device__ __forceinline__ int perm32(int rho) { const int n = rho >> 4, i = rho & 15; return 8 * (i >> 2) + 4 * n + (i & 3); }
struct Unit { int pm, pn; };
struct StaticOrder {
    int nM, nN, nwg, G, c;
    __host__ __device__ void init(int M_, int N_, int G_, int c_) { nM = M_ / BM; nN = N_ / BM; nwg = nM * nN; G = G_; c = c_; }
    __host__ __device__ bool next(int i, Unit& u) const {
        const long L = (long)i * G + c; if (L >= nwg) return false;
        int wgid = (int)L; { const int q = nwg / NXCD, r = nwg % NXCD, xcd = wgid % NXCD, off = wgid / NXCD; wgid = (xcd < r ? xcd * (q + 1) : r * (q + 1) + (xcd - r) * q) + off; }
        const int nig = WGM * nN, gid = wgid / nig, fm = gid * WGM, gsz = (nM - fm) < WGM ? (nM - fm) : WGM;
        u.pm = fm + ((wgid % nig) % gsz); u.pn = (wgid % nig) / gsz; return true;
    }
};
template <class Epi, bool PERM>
__device__ __forceinline__ void run_epi(const Epi& E, const f32x4 (&acc)[2][2][4][2], const Unit& u, int wr, int wc, int fr, int fq) {
#pragma unroll
    for (int ai = 0; ai < 2; ++ai)
#pragma unroll
        for (int m = 0; m < 4; ++m) {
            const int row = u.pm * BM + ai * HALF + wr * 64 + m * 16 + fr; float s1 = 0.f, s2 = 0.f;
#pragma unroll
            for (int bj = 0; bj < 2; ++bj)
#pragma unroll
                for (int n = 0; n < 2; ++n) { const int col = u.pn * BM + bj * HALF + wc * 32 + (PERM ? 8 * fq + 4 * n : 16 * n + 4 * fq); E.apply(row, col, acc[ai][bj][m][n], s1, s2); }
            if (Epi::STATS) { s1 += __shfl_xor(s1, 16); s1 += __shfl_xor(s1, 32); s2 += __shfl_xor(s2, 16); s2 += __shfl_xor(s2, 32); if (fq == 0) E.commit(row, u.pn * BM, s1, s2); }
        }
}
template <class Epi, bool PERM>
__device__ __forceinline__ void gemm_phase(LAS unsigned char* lds, const h16* Ag, const h16* Btg, int K, const StaticOrder& S, const Epi& E) {
    const int tid = threadIdx.x, wid = __builtin_amdgcn_readfirstlane(tid >> 6), lane = tid & 63, wr = wid >> 2, wc = wid & 3, fr = lane & 15, fq = lane >> 4;
    const int nt = K / BK;
    unsigned voffA[2], voffB[2];
#pragma unroll
    for (int i = 0; i < 2; ++i) { int R, Cc; stage_rc(tid * 16 + i * 8192, R, Cc); const int Rb = PERM ? ((R & ~31) + perm32(R & 31)) : R;
        voffA[i] = (unsigned)(R * K + Cc) * 2u; voffB[i] = (unsigned)(Rb * K + Cc) * 2u; }
    const size_t kstep = (size_t)(BK * 2), hstep = (size_t)HALF * K * 2, tstep = 2 * hstep;
    const unsigned ldsw = (unsigned)wid * 1024u;
    const int aoff = lds_byte(wr * 64 + fr, fq * 8), boff = lds_byte(wc * 32 + fr, fq * 8);
#define PG8_SA(b, h) (((b) * 2 + (h)) * HTB)
#define PG8_SB(b, h) ((4 + (b) * 2 + (h)) * HTB)
#define PG8_STAGE(bufoff, gbase, voff) do { _Pragma("unroll") for (int _i = 0; _i < 2; ++_i) \
        __builtin_amdgcn_global_load_lds((const unsigned*)((const char*)(gbase) + (voff)[_i]), (LAS unsigned*)(lds + (bufoff) + ldsw + _i * 8192), 16, 0, 0); } while (0)
#define PG8_LDA(dst, b, h) do { _Pragma("unroll") for (int m = 0; m < 4; ++m) _Pragma("unroll") for (int k = 0; k < 2; ++k) dst[m][k] = *(const LAS h16x8*)(lds + PG8_SA(b, h) + aoff + m * 2048 + k * 1024); } while (0)
#define PG8_LDB(dst, b, h) do { _Pragma("unroll") for (int n = 0; n < 2; ++n) _Pragma("unroll") for (int k = 0; k < 2; ++k) dst[n][k] = *(const LAS h16x8*)(lds + PG8_SB(b, h) + boff + n * 2048 + k * 1024); } while (0)
#define PG8_MMA(ai, bj, At, Bt) do { __builtin_amdgcn_s_setprio(1); _Pragma("unroll") for (int m = 0; m < 4; ++m) _Pragma("unroll") for (int n = 0; n < 2; ++n) _Pragma("unroll") for (int k = 0; k < 2; ++k) \
        acc[ai][bj][m][n] = __builtin_amdgcn_mfma_f32_16x16x32_f16(Bt[n][k], At[m][k], acc[ai][bj][m][n], 0, 0, 0); __builtin_amdgcn_s_setprio(0); } while (0)
#define PG8_WAIT_V(n) asm volatile("s_waitcnt vmcnt(" #n ")" ::: "memory")
#define PG8_WAIT_L(n) asm volatile("s_waitcnt lgkmcnt(" #n ")" ::: "memory")
#define PG8_BAR __builtin_amdgcn_s_barrier()
#define PG8_SCHED __builtin_amdgcn_sched_barrier(0)
    Unit cur, nxt; int ui = 0;
    if (!S.next(0, cur)) return;
    f32x4 acc[2][2][4][2];
#pragma unroll
    for (int a = 0; a < 2; ++a)
#pragma unroll
        for (int b = 0; b < 2; ++b)
#pragma unroll
            for (int m = 0; m < 4; ++m)
#pragma unroll
                for (int n = 0; n < 2; ++n) acc[a][b][m][n] = (f32x4){0.f, 0.f, 0.f, 0.f};
    h16x8 At[4][2], B0[2][2], B1[2][2];
    const char* cA = (const char*)Ag + (size_t)cur.pm * tstep; const char* cB = (const char*)Btg + (size_t)cur.pn * tstep;
    PG8_STAGE(PG8_SB(0, 0), cB, voffB); PG8_STAGE(PG8_SB(0, 1), cB + hstep, voffB); PG8_STAGE(PG8_SA(0, 0), cA, voffA); PG8_STAGE(PG8_SA(0, 1), cA + hstep, voffA);
    if (wr == 1) PG8_BAR;
    PG8_WAIT_V(2); PG8_BAR;
    PG8_STAGE(PG8_SB(1, 0), cB + kstep, voffB); PG8_STAGE(PG8_SA(1, 0), cA + kstep, voffA); PG8_STAGE(PG8_SB(1, 1), cB + hstep + kstep, voffB);
    PG8_WAIT_V(6); PG8_BAR;
    for (;;) {
        const bool has_next = S.next(ui + 1, nxt);
        const char* nA = has_next ? (const char*)Ag + (size_t)nxt.pm * tstep : cA; const char* nB = has_next ? (const char*)Btg + (size_t)nxt.pn * tstep : cB;
        for (int t = 0; t < nt; t += 2) {
            const bool last = (t == nt - 2);
            const char* a1 = cA + (size_t)(t + 1) * kstep;
            const char* a2 = last ? nA : cA + (size_t)(t + 2) * kstep; const char* b2 = last ? nB : cB + (size_t)(t + 2) * kstep;
            const char* a3 = a2 + kstep; const char* b3 = b2 + kstep;
            PG8_LDB(B0, 0, 0); PG8_LDB(B1, 0, 1); PG8_SCHED; PG8_LDA(At, 0, 0); PG8_STAGE(PG8_SA(1, 1), a1 + hstep, voffA);
            PG8_WAIT_V(8); PG8_WAIT_L(0); PG8_BAR; PG8_MMA(0, 0, At, B0); PG8_MMA(0, 1, At, B1); PG8_BAR; PG8_SCHED;
            PG8_LDA(At, 0, 1); PG8_STAGE(PG8_SB(0, 0), b2, voffB); PG8_STAGE(PG8_SB(0, 1), b2 + hstep, voffB); PG8_STAGE(PG8_SA(0, 0), a2, voffA);
            PG8_WAIT_V(8); PG8_WAIT_L(0); PG8_BAR; PG8_MMA(1, 0, At, B0); PG8_MMA(1, 1, At, B1); PG8_BAR; PG8_SCHED;
            PG8_LDB(B0, 1, 0); PG8_LDB(B1, 1, 1); PG8_SCHED; PG8_LDA(At, 1, 0); PG8_STAGE(PG8_SA(0, 1), a2 + hstep, voffA);
            PG8_WAIT_V(8); PG8_WAIT_L(0); PG8_BAR; PG8_MMA(0, 0, At, B0); PG8_MMA(0, 1, At, B1); PG8_BAR; PG8_SCHED;
            PG8_LDA(At, 1, 1); PG8_STAGE(PG8_SB(1, 0), b3, voffB); PG8_STAGE(PG8_SB(1, 1), b3 + hstep, voffB); PG8_STAGE(PG8_SA(1, 0), a3, voffA);
            PG8_WAIT_V(8); PG8_WAIT_L(0); PG8_BAR; PG8_MMA(1, 0, At, B0); PG8_MMA(1, 1, At, B1); PG8_BAR; PG8_SCHED;
        }
        if (wr == 0) PG8_BAR;
        run_epi<Epi, PERM>(E, acc, cur, wr, wc, fr, fq);
        if (!has_next) break;
#pragma unroll
        for (int a = 0; a < 2; ++a)
#pragma unroll
            for (int b = 0; b < 2; ++b)
#pragma unroll
                for (int m = 0; m < 4; ++m)
#pragma unroll
                    for (int n = 0; n < 2; ++n) acc[a][b][m][n] = (f32x4){0.f, 0.f, 0.f, 0.f};
        cur = nxt; cA = nA; cB = nB; ++ui;
        if (wr == 1) PG8_BAR;
    }
    PG8_WAIT_V(0);
    PG8_BAR;
#undef PG8_SA
#undef PG8_SB
#undef PG8_STAGE
#undef PG8_LDA
#undef PG8_LDB
#undef PG8_MMA
#undef PG8_WAIT_V
#undef PG8_WAIT_L
#undef PG8_BAR
#undef PG8_SCHED
}
}
template <class Epi, bool PERM>
__device__ __forceinline__ void fast_gemm_phase(const Ctx& C, const h16* A, const h16* Wt, int Mr, int N, int K, const Epi& E) {
    pg8::StaticOrder S; S.init(Mr, N, C.G, (int)blockIdx.x);
    pg8::gemm_phase<Epi, PERM>(C.lds, A, Wt, K, S, E);
    __syncthreads();
}

__device__ __forceinline__ void p0_transpose_item(const float* W, int K, int N, h16* WT, LAS float* scr, int item, int lane) {
    const int nblk = N / 32, kb = item / nblk, nb = item % nblk, k0 = 64 * kb, n0 = 32 * nb;
#pragma unroll 8
    for (int i = 0; i < 32; ++i) { const int kk = 2 * i + (lane >> 5); scr[kk * 33 + (lane & 31)] = W[(size_t)(k0 + kk) * N + n0 + (lane & 31)]; }
    asm volatile("s_waitcnt lgkmcnt(0)" ::: "memory");
    const int c = lane & 7;
#pragma unroll
    for (int j = 0; j < 4; ++j) { const int n = (lane >> 3) + 8 * j; const LAS float* s = scr + (8 * c) * 33 + n;
        u32x4 o; o.x = pk_h16(s[0 * 33], s[1 * 33]); o.y = pk_h16(s[2 * 33], s[3 * 33]); o.z = pk_h16(s[4 * 33], s[5 * 33]); o.w = pk_h16(s[6 * 33], s[7 * 33]);
        *(u32x4*)(WT + (size_t)(n0 + n) * K + k0 + 8 * c) = o; }
    asm volatile("s_waitcnt lgkmcnt(0)" ::: "memory");
}
__device__ __forceinline__ void phase0(const Ctx& C) {
    LAS float* scr = (LAS float*)(C.lds + C.wave * 16384);
    const int gw = C.vcu * NWAVES + C.wave, NGW = C.G * NWAVES;
    unsigned char* ws = C.ws;
    constexpr int I_HIN = (D / 64) * (N_HIN / 32), I_DD = (D / 64) * (D / 32), I_CIN = (D / 64) * (N_CIN / 32), I_W1 = (D / 64) * (FF / 32), I_W2 = (FF / 64) * (D / 32);
    constexpr int NITEMS = I_HIN + 2 * I_DD + I_CIN + 2 * I_W1 + 2 * I_W2;
    for (int it = gw; it < NITEMS; it += NGW) {
        int r = it;
        if (r < I_HIN) { p0_transpose_item(C.in[11], D, N_HIN, (h16*)(ws + WS_W_HIN), scr, r, C.lane); continue; } r -= I_HIN;
        if (r < I_DD) { p0_transpose_item(C.in[14], D, D, (h16*)(ws + WS_W_HOUT), scr, r, C.lane); continue; } r -= I_DD;
        if (r < I_CIN) { p0_transpose_item(C.in[15], D, N_CIN, (h16*)(ws + WS_W_CIN), scr, r, C.lane); continue; } r -= I_CIN;
        if (r < I_DD) { p0_transpose_item(C.in[20], D, D, (h16*)(ws + WS_W_COUT), scr, r, C.lane); continue; } r -= I_DD;
        if (r < 2 * I_W1) { const int l = r / I_W1; p0_transpose_item(C.in[9] + (size_t)l * D * FF, D, FF, (h16*)(ws + WS_W_W1 + (size_t)l * 8 * MiB), scr, r % I_W1, C.lane); continue; } r -= 2 * I_W1;
        { const int l = r / I_W2; p0_transpose_item(C.in[10] + (size_t)l * FF * D, FF, D, (h16*)(ws + WS_W_W2 + (size_t)l * 8 * MiB), scr, r % I_W2, C.lane); }
    }
    { const float* src = C.in[18]; h16* dst = (h16*)(ws + WS_W_WS);
      for (int i = (gw * 64 + C.lane) * 4; i < 8 * 128 * 128; i += NGW * 64 * 4) st_h16x4(dst + i, *(const f32x4*)(src + i)); }
    float* mod = C.ctlf + CW_MOD;
    for (int task = gw; task < 2 * 32 * 24; task += NGW) {
        const int l = task / (32 * 24), rem = task % (32 * 24), kc = rem / 24, cb = rem % 24;
        const int col = cb * 256 + C.lane * 4, k0 = kc * 32;
        const float* W = C.in[5] + (size_t)l * D * 6 * D;
        f32x4 acc[NCOND];
#pragma unroll
        for (int c = 0; c < NCOND; ++c) acc[c] = (f32x4){0.f, 0.f, 0.f, 0.f};
        for (int kk = 0; kk < 32; ++kk) {
            const f32x4 w = *(const f32x4*)(W + (size_t)(k0 + kk) * 6 * D + col);
#pragma unroll
            for (int c = 0; c < NCOND; ++c) { const float cv = (c == 0) ? C.in[4][k0 + kk] : C.in[3][(c - 1) * D + k0 + kk]; acc[c] += siluf_(cv) * w; }
        }
        if (kc == 0) { const f32x4 b = *(const f32x4*)(C.in[6] + (size_t)l * 6 * D + col);
#pragma unroll
            for (int c = 0; c < NCOND; ++c) acc[c] += b; }
#pragma unroll
        for (int c = 0; c < NCOND; ++c) { float* p = mod + ((size_t)l * NCOND + c) * 6 * D + col; atomicAdd(p, acc[c].x); atomicAdd(p + 1, acc[c].y); atomicAdd(p + 2, acc[c].z); atomicAdd(p + 3, acc[c].w); }
    }
}

__device__ __forceinline__ void phase1(const Ctx& C) {
    const int gw = C.vcu * NWAVES + C.wave, NGW = C.G * NWAVES, lane = C.lane;
    const float* mod = C.ctlf + CW_MOD; float* vec = C.vec; unsigned char* ws = C.ws;
    h16* AX = (h16*)(ws + WS_AX);
    const float* g0 = C.in[7];
    for (int row = gw; row < M; row += NGW) {
        const float* xr = row < M_CTX ? C.in[0] + (size_t)row * D : C.in[1] + (size_t)(row - M_CTX) * D;
        const float* mc = mod + (size_t)cond_of_row(row) * 6 * D;
        f32x4 v[4]; float s = 0.f;
#pragma unroll
        for (int j = 0; j < 4; ++j) { v[j] = *(const f32x4*)(xr + j * 256 + lane * 4); s += (v[j].x * v[j].x + v[j].y * v[j].y) + (v[j].z * v[j].z + v[j].w * v[j].w); }
        const float rstd = rsqrtf(wave_sum(s) * (1.0f / D) + EPS);
#pragma unroll
        for (int j = 0; j < 4; ++j) { const int col = j * 256 + lane * 4;
            const f32x4 g = *(const f32x4*)(g0 + col), sh = *(const f32x4*)(mc + col), sc = *(const f32x4*)(mc + D + col);
            st_h16x4(AX + (size_t)row * D + col, v[j] * rstd * g * (sc + 1.0f) + sh); }
    }
    for (int i = gw * 64 + lane; i < 3 * NCOND * D; i += NGW * 64) {
        const int vI = i / (NCOND * D), c = (i / D) % NCOND, col = i % D;
        const float g = vI == 0 ? C.in[8][col] : (vI == 1 ? C.in[7][D + col] : C.in[8][D + col]);
        const int l = vI == 0 ? 0 : 1, slot = vI == 1 ? 1 : 4;
        vec[VW_GN + i] = g * (1.0f + mod[((size_t)l * NCOND + c) * 6 * D + slot * D + col]);
    }
    for (int i = gw * 64 + lane; i < 2 * D; i += NGW * 64) { const float l0 = C.in[12][i], l1 = C.in[12][2 * D + i]; vec[VW_LB + i] = 1.0f / (1.0f + __expf(l1 - l0)); }
    constexpr int NB = 2 * FF + N_CIN;
    for (int task = gw; task < NB; task += NGW) {
        const h16* wrow; const float* sh; float* dst; int stride;
        if (task < FF) { wrow = (const h16*)(ws + WS_W_W1) + (size_t)task * D; sh = mod + 3 * D; dst = vec + VW_BMLP + task; stride = FF; }
        else if (task < 2 * FF) { const int n = task - FF; wrow = (const h16*)(ws + WS_W_W1 + 8 * MiB) + (size_t)n * D; sh = mod + (size_t)NCOND * 6 * D + 3 * D; dst = vec + VW_BMLP + NCOND * FF + n; stride = FF; }
        else { const int n = task - 2 * FF; wrow = (const h16*)(ws + WS_W_CIN) + (size_t)n * D; sh = mod + (size_t)NCOND * 6 * D; dst = vec + VW_BCM + n; stride = N_CIN; }
        float w[16];
        { const h16x8 a = *(const h16x8*)(wrow + lane * 8), b = *(const h16x8*)(wrow + 512 + lane * 8);
#pragma unroll
          for (int j = 0; j < 8; ++j) { w[j] = (float)a[j]; w[8 + j] = (float)b[j]; } }
#pragma unroll
        for (int c = 0; c < NCOND; ++c) { const float* s = sh + (size_t)c * 6 * D; float p = 0.f;
#pragma unroll
            for (int j = 0; j < 8; ++j) { p += w[j] * s[lane * 8 + j]; p += w[8 + j] * s[512 + lane * 8 + j]; }
            p = wave_sum(p); if (lane == 0) dst[(size_t)c * stride] = p; }
    }
}

__device__ __forceinline__ void naive_scan_phase(const Ctx& C) {
    LAS float* sf = (LAS float*)C.lds; LAS float* sk = sf + 8 * 128; LAS float* sq = sk + 8 * 128; LAS float* sv = sq + 8 * 128; LAS float* red = sv + 8 * 128;
    unsigned char* ws = C.ws; const int tid = C.tid;
    const h16* Q = (const h16*)(ws + WS_Q); const bf16_t* V = (const bf16_t*)(ws + WS_V);
    const h16* ZF = (const h16*)C.out; const h16* ZB = ZF + (size_t)M * D;
    const float* lbv = C.vec + VW_LB;
    const int kq = tid >> 7, vv = tid & 127;
    for (int item = C.vcu; item < (MK_SCAN_HYBRID ? 64 : 320); item += C.G) {
        int seq, h, dir;
        if (item < 64) { seq = 16 + item / 16; h = (item % 16) >> 1; dir = item & 1; } else { const int i2 = item - 64; seq = i2 / 16; h = (i2 % 16) >> 1; dir = i2 & 1; }
        const int L = seq < 16 ? 256 : 4096, row0 = seq < 16 ? seq * 256 : M_CTX + (seq - 16) * 4096;
        const h16* Z = dir ? ZB : ZF; h16* O = (h16*)(ws + (dir ? WS_AY : WS_AX));
        float S[32];
        if (seq < 16) {
#pragma unroll
            for (int i = 0; i < 32; ++i) S[i] = 0.f;
        } else { const float* s0 = C.in[2] + ((((size_t)(seq - 16) * 2 + dir) * NH + h) * HD) * HD;
#pragma unroll
            for (int i = 0; i < 32; ++i) S[i] = s0[(size_t)(kq * 32 + i) * HD + vv]; }
        for (int tb = 0; tb < L; tb += 8) {
            __syncthreads();
            if (tid < 128) { const float lb = lbv[dir * D + h * HD + tid];
#pragma unroll
                for (int j = 0; j < 8; ++j) { const int t = dir ? L - 1 - (tb + j) : tb + j; const size_t off = (size_t)(row0 + t) * D + h * HD + tid;
                    const float f = lb + (1.0f - lb) * sigmoidf_((float)Z[off]); sf[j * 128 + tid] = f; sk[j * 128 + tid] = 1.0f - f; sq[j * 128 + tid] = (float)Q[off]; }
            } else if (tid < 256) { const int c = tid - 128;
#pragma unroll
                for (int j = 0; j < 8; ++j) { const int t = dir ? L - 1 - (tb + j) : tb + j; sv[j * 128 + c] = bf2f(V[(size_t)(row0 + t) * D + h * HD + c]); }
            }
            __syncthreads();
#pragma unroll 1
            for (int j = 0; j < 8; ++j) { const float vval = sv[j * 128 + vv]; float part = 0.f;
#pragma unroll
                for (int i = 0; i < 32; ++i) { const int k = kq * 32 + i; S[i] = sf[j * 128 + k] * S[i] + sk[j * 128 + k] * vval; part += sq[j * 128 + k] * S[i]; }
                red[(kq * 8 + j) * 128 + vv] = part; }
            __syncthreads();
            if (tid < 128) {
#pragma unroll
                for (int j = 0; j < 8; ++j) { const int t = dir ? L - 1 - (tb + j) : tb + j;
                    const float o = (red[(0 * 8 + j) * 128 + tid] + red[(1 * 8 + j) * 128 + tid]) + (red[(2 * 8 + j) * 128 + tid] + red[(3 * 8 + j) * 128 + tid]);
                    if (!(MK_SCAN_DBG == 1 && seq < 16 && dir == 0) && !(MK_SCAN_DBG == 2 && seq < 16 && dir == 1)) O[(size_t)(row0 + t) * D + h * HD + tid] = (h16)o; }
            }
        }
        if (seq < 16 && MK_SCAN_DBG != 3) { float* so = C.out + (size_t)M * D + ((((size_t)seq * 2 + dir) * NH + h) * HD) * HD;
#pragma unroll
            for (int i = 0; i < 32; ++i) so[(size_t)(kq * 32 + i) * HD + vv] = S[i]; }
    }
    __syncthreads();
}
__device__ __forceinline__ void naive_combine_phase(const Ctx& C) {
    unsigned char* ws = C.ws; const int gw = C.vcu * NWAVES + C.wave, NGW = C.G * NWAVES, lane = C.lane;
    h16* AX = (h16*)(ws + WS_AX); const h16* AY = (const h16*)(ws + WS_AY); const h16* Gt = (const h16*)(ws + WS_G); const float* og = C.in[13];
    for (int task = gw + ((MK_SCAN_HYBRID || MK_SCAN_DBG == 4) ? M_CTX * NH : 0); task < M * NH; task += NGW) {
        const int row = task >> 3, h = task & 7; const size_t off = (size_t)row * D + h * HD + lane * 2;
        const h16x2 a = *(const h16x2*)(AX + off), b = *(const h16x2*)(AY + off), g = *(const h16x2*)(Gt + off);
        if (MK_SCAN_DBG == 5 && row < M_CTX) { *(unsigned*)(AX + off) = pk_h16((float)a.x * og[h * HD + lane * 2] * (float)g.x, (float)a.y * og[h * HD + lane * 2 + 1] * (float)g.y); continue; }
        const float o0 = (float)a.x + ((MK_SCAN_DBG == 6 && row < M_CTX) ? 0.f : (float)b.x), o1 = (float)a.y + ((MK_SCAN_DBG == 6 && row < M_CTX) ? 0.f : (float)b.y);
        const float r = rsqrtf(wave_sum(o0 * o0 + o1 * o1) * (1.0f / HD) + EPS);
        *(unsigned*)(AX + off) = pk_h16(o0 * r * og[h * HD + lane * 2] * (float)g.x, o1 * r * og[h * HD + lane * 2 + 1] * (float)g.y);
    }
}


namespace fs {
typedef __bf16 b16x8 __attribute__((ext_vector_type(8)));
constexpr int QS = 272, TS = 144, SS = 272;
constexpr int L_Q = 0, L_K = L_Q + 64 * QS, L_KT = L_K + 64 * QS, L_VT = L_KT + 128 * TS, L_P = L_VT + 128 * TS, L_ST = L_P + 64 * TS, L_EM = L_ST + 128 * SS, L_ET = L_EM + 512,
              L_SEG = L_ET + 512, L_RED = L_SEG + 4096, L_END = L_RED + 2048;
static_assert(L_END <= 131072, "scan LDS");
constexpr int NS = 8, TSUP = 512;
constexpr float TINY = 1e-30f;
constexpr size_t U_SLOT_FLOATS = 128 * 128, U_DT_OFF = (size_t)512 * U_SLOT_FLOATS;
__device__ __forceinline__ int uslot(int seql, int h, int dir, int j) { return ((seql * NH + h) * 2 + dir) * NS + j; }

struct Raw { unsigned q[8], z[8], v[8]; };
typedef __amdgpu_buffer_rsrc_t rsrc_t;
__device__ __forceinline__ rsrc_t mk_rsrc(const void* p, unsigned bytes) { return __builtin_amdgcn_make_buffer_rsrc((void*)p, 0, (int)bytes, 0x00020000); }
template <bool NEEDQ>
__device__ __forceinline__ void load_raw(Raw& r, rsrc_t rQ, rsrc_t rZ, rsrc_t rV, int cbase, int dir, int h, int sg, int lane) {
    const unsigned voff = (unsigned)lane * 4u;
#pragma unroll
    for (int j = 0; j < 8; ++j) { const int p = 8 * sg + j, row = dir ? cbase + 63 - p : cbase + p; const unsigned soff = (unsigned)(row * D + h * HD) * 2u;
        r.z[j] = __builtin_amdgcn_raw_buffer_load_b32(rZ, voff, soff, 0); r.v[j] = __builtin_amdgcn_raw_buffer_load_b32(rV, voff, soff, 0); if (NEEDQ) r.q[j] = __builtin_amdgcn_raw_buffer_load_b32(rQ, voff, soff, 0); }
}
__device__ __forceinline__ b16x8 ldf(LAS const unsigned char* p) { return *(const LAS b16x8*)p; }
#define FS_MFMA(a, b, c) __builtin_amdgcn_mfma_f32_16x16x32_bf16(a, b, c, 0, 0, 0)
#define FS_BAR() do { asm volatile("s_waitcnt lgkmcnt(0)" ::: "memory"); __builtin_amdgcn_s_barrier(); asm volatile("" ::: "memory"); } while (0)

__device__ __forceinline__ void state_update(LAS unsigned char* lds, f32x4 (&S)[8], int wave, int fr, int fq) {
#pragma unroll
    for (int kt = 0; kt < 8; ++kt) { const f32x4 et = *(const LAS f32x4*)(lds + L_ET + (16 * kt + 4 * fq) * 4); S[kt] = S[kt] * et; }
#pragma unroll
    for (int ks = 0; ks < 2; ++ks) { const b16x8 B = ldf(lds + L_VT + (16 * wave + fr) * TS + ks * 64 + fq * 16);
#pragma unroll
        for (int kt = 0; kt < 8; ++kt) { const b16x8 A = ldf(lds + L_KT + (16 * kt + fr) * TS + ks * 64 + fq * 16); S[kt] = FS_MFMA(A, B, S[kt]); } }
}
__device__ __forceinline__ void write_kt_vt(LAS unsigned char* lds, const float (&kh0)[8], const float (&kh1)[8], const Raw& raw, int sg, int lane) {
    u32x4 a, b; a.x = pk_bf16(kh0[0], kh0[1]); a.y = pk_bf16(kh0[2], kh0[3]); a.z = pk_bf16(kh0[4], kh0[5]); a.w = pk_bf16(kh0[6], kh0[7]);
    b.x = pk_bf16(kh1[0], kh1[1]); b.y = pk_bf16(kh1[2], kh1[3]); b.z = pk_bf16(kh1[4], kh1[5]); b.w = pk_bf16(kh1[6], kh1[7]);
    *(LAS u32x4*)(lds + L_KT + (2 * lane) * TS + sg * 16) = a; *(LAS u32x4*)(lds + L_KT + (2 * lane + 1) * TS + sg * 16) = b;
    u32x4 c, d;
    c.x = (raw.v[0] & 0xffffu) | (raw.v[1] << 16); c.y = (raw.v[2] & 0xffffu) | (raw.v[3] << 16); c.z = (raw.v[4] & 0xffffu) | (raw.v[5] << 16); c.w = (raw.v[6] & 0xffffu) | (raw.v[7] << 16);
    d.x = (raw.v[0] >> 16) | (raw.v[1] & 0xffff0000u); d.y = (raw.v[2] >> 16) | (raw.v[3] & 0xffff0000u); d.z = (raw.v[4] >> 16) | (raw.v[5] & 0xffff0000u); d.w = (raw.v[6] >> 16) | (raw.v[7] & 0xffff0000u);
    *(LAS u32x4*)(lds + L_VT + (2 * lane) * TS + sg * 16) = c; *(LAS u32x4*)(lds + L_VT + (2 * lane + 1) * TS + sg * 16) = d;
}

__device__ __forceinline__ void passA_item(const Ctx& C, int seql, int h, int dir, int j) {
    LAS unsigned char* lds = C.lds; const int wave = C.wave, lane = C.lane, fr = lane & 15, fq = lane >> 4, sg = wave;
    const rsrc_t rZ = mk_rsrc((const h16*)C.out + (dir ? (size_t)M * D : 0), ACT_BYTES), rV = mk_rsrc(C.ws + WS_V, ACT_BYTES);
    const float* lbv = C.vec + VW_LB; const float lb0 = lbv[dir * D + h * HD + 2 * lane], lb1 = lbv[dir * D + h * HD + 2 * lane + 1];
    const int base = M_CTX + seql * 4096 + j * TSUP, nc = TSUP / 64;
    f32x4 S[8];
#pragma unroll
    for (int kt = 0; kt < 8; ++kt) S[kt] = (f32x4){0.f, 0.f, 0.f, 0.f};
    float dt0 = 1.f, dt1 = 1.f;
    Raw raw; load_raw<false>(raw, rV, rZ, rV, dir ? base + TSUP - 64 : base, dir, h, sg, lane);
    for (int c = 0; c < nc; ++c) {
        float e0[8], e1[8];
        { float f0[8], f1[8];
#pragma unroll
          for (int jj = 0; jj < 8; ++jj) { const h16x2 hz = __builtin_bit_cast(h16x2, raw.z[jj]); f0[jj] = lb0 + (1.f - lb0) * sigmoidf_((float)hz.x); f1[jj] = lb1 + (1.f - lb1) * sigmoidf_((float)hz.y); }
          e0[7] = 1.f; e1[7] = 1.f;
#pragma unroll
          for (int jj = 6; jj >= 0; --jj) { e0[jj] = e0[jj + 1] * f0[jj + 1]; e1[jj] = e1[jj + 1] * f1[jj + 1]; }
          *(LAS f32x2*)(lds + L_SEG + (sg * 128 + 2 * lane) * 4) = (f32x2){e0[0] * f0[0], e1[0] * f1[0]};
#pragma unroll
          for (int jj = 0; jj < 8; ++jj) { e0[jj] *= (1.f - f0[jj]); e1[jj] *= (1.f - f1[jj]); }
        }
        FS_BAR();
        float o0 = 1.f, o1 = 1.f, t0 = 1.f, t1 = 1.f;
#pragma unroll
        for (int s2 = 0; s2 < 8; ++s2) { const f32x2 t = *(const LAS f32x2*)(lds + L_SEG + (s2 * 128 + 2 * lane) * 4); t0 *= t.x; t1 *= t.y; if (s2 > sg) { o0 *= t.x; o1 *= t.y; } }
#pragma unroll
        for (int jj = 0; jj < 8; ++jj) { e0[jj] *= o0; e1[jj] *= o1; }
        write_kt_vt(lds, e0, e1, raw, sg, lane);
        if (sg == 0) *(LAS f32x2*)(lds + L_ET + 2 * lane * 4) = (f32x2){t0, t1};
        dt0 *= t0; dt1 *= t1;
        FS_BAR();
        if (c + 1 < nc) load_raw<false>(raw, rV, rZ, rV, dir ? base + TSUP - 64 * (c + 2) : base + 64 * (c + 1), dir, h, sg, lane);
        state_update(lds, S, wave, fr, fq);
        FS_BAR();
    }
    { const rsrc_t rU = mk_rsrc(C.ws + WS_AY, ACT_BYTES); const unsigned vo = (unsigned)(wave * 64 + lane) * 16u, so = (unsigned)uslot(seql, h, dir, j) * 65536u;
#pragma unroll
      for (int kt = 0; kt < 8; ++kt) __builtin_amdgcn_raw_buffer_store_b128(__builtin_bit_cast(u32x4, S[kt]), rU, vo, so + kt * 8192u, 0); }
    if (sg == 0) { float* Dt = (float*)(C.ws + WS_AY) + U_DT_OFF + (size_t)uslot(seql, h, dir, j) * 128; *(f32x2*)(Dt + 2 * lane) = (f32x2){dt0, dt1}; }
}
__device__ __forceinline__ void passA_phase(const Ctx& C) {
    for (int it = C.vcu; it < 4 * NH * 2 * (NS - 1); it += C.G) {
        const int jj = it % (NS - 1), r = it / (NS - 1), dir = r & 1, h = (r >> 1) & 7, seql = r >> 4;
        passA_item(C, seql, h, dir, dir ? jj + 1 : jj);
    }
}

template <int DBG, int dir>
__device__ __forceinline__ void passC_dir(const Ctx& C, int seq, int h, int t0, int T, int jsup) {
    LAS unsigned char* lds = C.lds; const int wave = C.wave, lane = C.lane, fr = lane & 15, fq = lane >> 4, sg = wave;
    const rsrc_t rQ = mk_rsrc(C.ws + WS_Q, ACT_BYTES), rV = mk_rsrc(C.ws + WS_V, ACT_BYTES), rG = mk_rsrc(C.ws + WS_G, ACT_BYTES), rX = mk_rsrc(C.ws + (DBG == 2 ? WS_AY : WS_AX), ACT_BYTES), rU = mk_rsrc(C.ws + WS_AY, ACT_BYTES);
    const float* lbv = C.vec + VW_LB; const float* og = C.in[13] + h * HD;
    const int seqbase = seq < 16 ? seq * 256 : M_CTX + (seq - 16) * 4096, base = seqbase + t0, nc = T / 64;
    {
        const rsrc_t rZ = mk_rsrc((const h16*)C.out + (dir ? (size_t)M * D : 0), ACT_BYTES);
        const float lb0 = lbv[dir * D + h * HD + 2 * lane], lb1 = lbv[dir * D + h * HD + 2 * lane + 1];
        const unsigned voX = (unsigned)((dir ? 15 - fr : fr) * D + 16 * wave + 4 * fq) * 2u;
        Raw raw; load_raw<true>(raw, rQ, rZ, rV, dir ? base + T - 64 : base, dir, h, sg, lane);
        f32x4 S[8];
        if (seq < 16) {
#pragma unroll
            for (int kt = 0; kt < 8; ++kt) S[kt] = (f32x4){0.f, 0.f, 0.f, 0.f};
        } else {
            const int seql = seq - 16;
            const float* s0 = C.in[2] + ((((size_t)seql * 2 + dir) * NH + h) * HD) * HD;
#pragma unroll
            for (int kt = 0; kt < 8; ++kt) { const float* sp = s0 + (size_t)(16 * kt + 4 * fq) * HD + 16 * wave + fr; S[kt] = (f32x4){sp[0], sp[HD], sp[2 * HD], sp[3 * HD]}; }
            const int nchain = dir ? NS - 1 - jsup : jsup; const unsigned vo = (unsigned)(wave * 64 + lane) * 16u;
            for (int ii = 0; ii < nchain; ++ii) { const int i = dir ? NS - 1 - ii : ii; const unsigned sl = (unsigned)uslot(seql, h, dir, i);
#pragma unroll
                for (int kt = 0; kt < 8; ++kt) { const f32x4 u = __builtin_bit_cast(f32x4, __builtin_amdgcn_raw_buffer_load_b128(rU, vo, sl * 65536u + kt * 8192u, 0)),
                        d = __builtin_bit_cast(f32x4, __builtin_amdgcn_raw_buffer_load_b128(rU, (unsigned)fq * 16u, (unsigned)(U_DT_OFF * 4) + sl * 512u + kt * 64u, 0)); S[kt] = d * S[kt] + u; } }
        }
        for (int c = 0; c < nc; ++c) {
            const int cbase = dir ? base + T - 64 * (c + 1) : base + 64 * c;
            float e0[8], e1[8], k0[8], k1[8];
            { float f0[8], f1[8];
#pragma unroll
              for (int j = 0; j < 8; ++j) { const h16x2 hz = __builtin_bit_cast(h16x2, raw.z[j]); f0[j] = lb0 + (1.f - lb0) * sigmoidf_((float)hz.x); f1[j] = lb1 + (1.f - lb1) * sigmoidf_((float)hz.y); k0[j] = 1.f - f0[j]; k1[j] = 1.f - f1[j]; }
              float tot0, tot1;
              if (sg < 4) { e0[7] = 1.f; e1[7] = 1.f;
#pragma unroll
                  for (int j = 6; j >= 0; --j) { e0[j] = e0[j + 1] * f0[j + 1]; e1[j] = e1[j + 1] * f1[j + 1]; }
                  tot0 = e0[0] * f0[0]; tot1 = e1[0] * f1[0];
              } else { e0[0] = f0[0]; e1[0] = f1[0];
#pragma unroll
                  for (int j = 1; j < 8; ++j) { e0[j] = e0[j - 1] * f0[j]; e1[j] = e1[j - 1] * f1[j]; }
                  tot0 = e0[7]; tot1 = e1[7]; }
              *(LAS f32x2*)(lds + L_SEG + (sg * 128 + 2 * lane) * 4) = (f32x2){tot0, tot1};
            }
            FS_BAR();
            { float em0 = 1.f, em1 = 1.f, el0 = 1.f, el1 = 1.f, o0 = 1.f, o1 = 1.f;
#pragma unroll
              for (int s2 = 0; s2 < 8; ++s2) { const f32x2 t = *(const LAS f32x2*)(lds + L_SEG + (s2 * 128 + 2 * lane) * 4);
                  if (s2 < 4) { em0 *= t.x; em1 *= t.y; if (s2 > sg) { o0 *= t.x; o1 *= t.y; } } else { el0 *= t.x; el1 *= t.y; if (s2 < sg) { o0 *= t.x; o1 *= t.y; } } }
              float kh0[8], kh1[8];
#pragma unroll
              for (int j = 0; j < 8; ++j) { const h16x2 hq = __builtin_bit_cast(h16x2, raw.q[j]); const float q0 = (float)hq.x, q1 = (float)hq.y;
                  const float r0 = e0[j] * o0, r1 = e1[j] * o1; float qt0, qt1, kt0, kt1;
                  if (sg < 4) { qt0 = q0 * rcpf(fmaxf(r0, TINY)); qt1 = q1 * rcpf(fmaxf(r1, TINY)); kt0 = k0[j] * r0; kt1 = k1[j] * r1; }
                  else { qt0 = q0 * r0; qt1 = q1 * r1; kt0 = k0[j] * rcpf(fmaxf(r0, TINY)); kt1 = k1[j] * rcpf(fmaxf(r1, TINY)); }
                  kh0[j] = kt0 * el0; kh1[j] = kt1 * el1;
                  const int p = 8 * sg + j;
                  *(LAS unsigned*)(lds + L_Q + p * QS + lane * 4) = pk_bf16(qt0, qt1); *(LAS unsigned*)(lds + L_K + p * QS + lane * 4) = pk_bf16(kt0, kt1); }
              write_kt_vt(lds, kh0, kh1, raw, sg, lane);
              if (sg == 0) { *(LAS f32x2*)(lds + L_EM + 2 * lane * 4) = (f32x2){em0, em1}; *(LAS f32x2*)(lds + L_ET + 2 * lane * 4) = (f32x2){em0 * el0, em1 * el1}; }
            }
            FS_BAR();
            if (c + 1 < nc) load_raw<true>(raw, rQ, rZ, rV, dir ? base + T - 64 * (c + 2) : base + 64 * (c + 1), dir, h, sg, lane);
            __builtin_amdgcn_sched_barrier(0);
#pragma unroll
            for (int kt = 0; kt < 8; ++kt) { const f32x4 em = *(const LAS f32x4*)(lds + L_EM + (16 * kt + 4 * fq) * 4); const f32x4 sv = S[kt] * em;
                u32x2 w; w.x = pk_bf16(sv.x, sv.y); w.y = pk_bf16(sv.z, sv.w); *(LAS u32x2*)(lds + L_ST + (16 * wave + fr) * SS + (16 * kt + 4 * fq) * 2) = w; }
            __builtin_amdgcn_sched_barrier(0);
            { const int pt = wave >> 1;
#pragma unroll
              for (int e = 0; e < 2; ++e) { const int ppt = 2 * (wave & 1) + e; f32x4 a = (f32x4){0.f, 0.f, 0.f, 0.f};
#pragma unroll
                  for (int ks = 0; ks < 4; ++ks) { const b16x8 A = ldf(lds + L_K + (16 * ppt + fr) * QS + ks * 64 + fq * 16), B = ldf(lds + L_Q + (16 * pt + fr) * QS + ks * 64 + fq * 16); a = FS_MFMA(A, B, a); }
                  const int p = 16 * pt + fr, pp = 16 * ppt + 4 * fq;
                  a.x = (pp + 0 <= p) ? a.x : 0.f; a.y = (pp + 1 <= p) ? a.y : 0.f; a.z = (pp + 2 <= p) ? a.z : 0.f; a.w = (pp + 3 <= p) ? a.w : 0.f;
                  u32x2 w; w.x = pk_bf16(a.x, a.y); w.y = pk_bf16(a.z, a.w); *(LAS u32x2*)(lds + L_P + p * TS + pp * 2) = w; } }
            __builtin_amdgcn_sched_barrier(0);
            FS_BAR();
            f32x4 o[4];
#pragma unroll
            for (int pt = 0; pt < 4; ++pt) o[pt] = (f32x4){0.f, 0.f, 0.f, 0.f};
#pragma unroll
            for (int ks = 0; ks < 4; ++ks) { const b16x8 A = ldf(lds + L_ST + (16 * wave + fr) * SS + ks * 64 + fq * 16);
#pragma unroll
                for (int pt = 0; pt < 4; ++pt) { const b16x8 B = ldf(lds + L_Q + (16 * pt + fr) * QS + ks * 64 + fq * 16); o[pt] = FS_MFMA(A, B, o[pt]); } }
#pragma unroll
            for (int ks = 0; ks < 2; ++ks) { const b16x8 A = ldf(lds + L_VT + (16 * wave + fr) * TS + ks * 64 + fq * 16);
#pragma unroll
                for (int pt = 0; pt < 4; ++pt) { const b16x8 B = ldf(lds + L_P + (16 * pt + fr) * TS + ks * 64 + fq * 16); o[pt] = FS_MFMA(A, B, o[pt]); } }
            __builtin_amdgcn_sched_barrier(0);
            if (!dir || DBG == 2 || DBG == 3) {
                if (DBG != 3) {
#pragma unroll
                for (int pt = 0; pt < 4; ++pt) { u32x2 w; w.x = pk_h16(o[pt].x, o[pt].y); w.y = pk_h16(o[pt].z, o[pt].w);
                    __builtin_amdgcn_raw_buffer_store_b64(w, rX, voX, (unsigned)((cbase + (dir ? 48 - 16 * pt : 16 * pt)) * D + h * HD) * 2u, 0); }
                }
                state_update(lds, S, wave, fr, fq);
                FS_BAR();
            } else {
                h16x4 of[4], gg[4];
#pragma unroll
                for (int pt = 0; pt < 4; ++pt) { const unsigned so = (unsigned)((cbase + 48 - 16 * pt) * D + h * HD) * 2u;
                    of[pt] = __builtin_bit_cast(h16x4, __builtin_amdgcn_raw_buffer_load_b64(rX, voX, so, 0)); gg[pt] = __builtin_bit_cast(h16x4, __builtin_amdgcn_raw_buffer_load_b64(rG, voX, so, 0)); }
#pragma unroll
                for (int pt = 0; pt < 4; ++pt) {
                    o[pt].x += (float)of[pt].x; o[pt].y += (float)of[pt].y; o[pt].z += (float)of[pt].z; o[pt].w += (float)of[pt].w;
                    float ss = (o[pt].x * o[pt].x + o[pt].y * o[pt].y) + (o[pt].z * o[pt].z + o[pt].w * o[pt].w);
                    ss += __shfl_xor(ss, 16); ss += __shfl_xor(ss, 32);
                    if (fq == 0) *(LAS float*)(lds + L_RED + (wave * 64 + 16 * pt + fr) * 4) = ss; }
                state_update(lds, S, wave, fr, fq);
                FS_BAR();
                const f32x4 ogv = *(const f32x4*)(og + 16 * wave + 4 * fq);
#pragma unroll
                for (int pt = 0; pt < 4; ++pt) { const int p = 16 * pt + fr; float ss = 0.f;
#pragma unroll
                    for (int w2 = 0; w2 < 8; ++w2) ss += *(const LAS float*)(lds + L_RED + (w2 * 64 + p) * 4);
                    const float rs = rsqrtf(ss * (1.0f / HD) + EPS);
                    f32x4 r; r.x = o[pt].x * rs * ogv.x * (float)gg[pt].x; r.y = o[pt].y * rs * ogv.y * (float)gg[pt].y; r.z = o[pt].z * rs * ogv.z * (float)gg[pt].z; r.w = o[pt].w * rs * ogv.w * (float)gg[pt].w;
                    if (DBG == 5) { r.x = o[pt].x * rs; r.y = o[pt].y * rs; r.z = o[pt].z * rs; r.w = o[pt].w * rs; }
                    if (DBG == 6) { r = o[pt]; }
                    u32x2 w; w.x = pk_h16(r.x, r.y); w.y = pk_h16(r.z, r.w);
                    __builtin_amdgcn_raw_buffer_store_b64(w, rX, voX, (unsigned)((cbase + 48 - 16 * pt) * D + h * HD) * 2u, 0); }
                FS_BAR();
            }
        }
        if (seq < 16 && (DBG == 0 || DBG == 3)) { float* so = C.out + (size_t)M * D + ((((size_t)seq * 2 + dir) * NH + h) * HD) * HD;
#pragma unroll
            for (int kt = 0; kt < 8; ++kt) { float* sp = so + (size_t)(16 * kt + 4 * fq) * HD + 16 * wave + fr; sp[0] = S[kt].x; sp[HD] = S[kt].y; sp[2 * HD] = S[kt].z; sp[3 * HD] = S[kt].w; } }
        asm volatile("s_waitcnt vmcnt(0)" ::: "memory");
        __syncthreads();
    }
}
template <int DBG>
__device__ __forceinline__ void passC_item(const Ctx& C, int seq, int h, int t0, int T, int jsup) {
    if (DBG != 2 && DBG < 4) passC_dir<DBG, 0>(C, seq, h, t0, T, jsup);
    if (DBG != 1) passC_dir<DBG, 1>(C, seq, h, t0, T, jsup);
}
__device__ __forceinline__ void passC_phase(const Ctx& C) {
    for (int it = C.vcu; it < 256 + 128; it += C.G) {
        if (it < 256) passC_item<0>(C, 16 + (it >> 6), (it >> 3) & 7, (it & 7) * TSUP, TSUP, it & 7);
        else { const int i2 = it - 256; passC_item<0>(C, i2 >> 3, i2 & 7, 0, 256, 0); }
    }
}
#undef FS_MFMA
#undef FS_BAR
}

__device__ __forceinline__ void naive_spatial_phase(const Ctx& C) {
    LAS float* As = (LAS float*)C.lds; LAS float* Bs = As + 16 * 132;
    unsigned char* ws = C.ws; const int tid = C.tid, ty = tid >> 5, tx = tid & 31;
    const h16* U = (const h16*)(ws + WS_U); const h16* V2 = (const h16*)(ws + WS_V2); const h16* Wsp = (const h16*)(ws + WS_W_WS); h16* AX = (h16*)(ws + WS_AX);
    const float* vs1 = C.ctlf + CW_VS1; const float* vs2 = C.ctlf + CW_VS2; const float* lng = C.in[16]; const float* lnb = C.in[17]; const float* bs = C.in[19];
    for (int item = C.vcu; item < (M / 128) * 8; item += C.G) {
        const int ch = item >> 3, g = item & 7, r0 = ch * 128;
        f32x4 acc[8];
#pragma unroll
        for (int i = 0; i < 8; ++i) acc[i] = (f32x4){0.f, 0.f, 0.f, 0.f};
        const int r = tid >> 2, kk = (tid & 3) * 4;
        for (int k0 = 0; k0 < 128; k0 += 16) {
            const h16x4 a = *(const h16x4*)(Wsp + ((size_t)g * 128 + r) * 128 + k0 + kk);
            const int qq = tid >> 5, c4 = (tid & 31) * 4, qrow = r0 + k0 + qq;
            const h16x4 vr = *(const h16x4*)(V2 + (size_t)qrow * D + g * 128 + c4);
            const float mu = vs1[qrow] * (1.0f / D), var = vs2[qrow] * (1.0f / D) - mu * mu, rs = rsqrtf(var + EPS);
            const f32x4 lg = *(const f32x4*)(lng + g * 128 + c4), lb = *(const f32x4*)(lnb + g * 128 + c4);
            f32x4 vn; vn.x = ((float)vr.x - mu) * rs * lg.x + lb.x; vn.y = ((float)vr.y - mu) * rs * lg.y + lb.y; vn.z = ((float)vr.z - mu) * rs * lg.z + lb.z; vn.w = ((float)vr.w - mu) * rs * lg.w + lb.w;
            __syncthreads();
#pragma unroll
            for (int j = 0; j < 4; ++j) As[(kk + j) * 132 + r] = (float)a[j];
            *(LAS f32x4*)(Bs + qq * 132 + c4) = vn;
            __syncthreads();
#pragma unroll 2
            for (int k = 0; k < 16; ++k) {
                const f32x4 a0 = *(LAS f32x4*)(As + k * 132 + ty * 8), a1 = *(LAS f32x4*)(As + k * 132 + ty * 8 + 4), bv = *(LAS f32x4*)(Bs + k * 132 + tx * 4);
                acc[0] += a0.x * bv; acc[1] += a0.y * bv; acc[2] += a0.z * bv; acc[3] += a0.w * bv;
                acc[4] += a1.x * bv; acc[5] += a1.y * bv; acc[6] += a1.z * bv; acc[7] += a1.w * bv;
            }
        }
#pragma unroll
        for (int i = 0; i < 8; ++i) { const int p = ty * 8 + i; const size_t off = (size_t)(r0 + p) * D + g * 128 + tx * 4;
            const h16x4 u = *(const h16x4*)(U + off); const float b = bs[g * 128 + p];
            f32x4 o; o.x = (float)u.x * (acc[i].x + b); o.y = (float)u.y * (acc[i].y + b); o.z = (float)u.z * (acc[i].z + b); o.w = (float)u.w * (acc[i].w + b);
            st_h16x4(AX + off, o); }
    }
    __syncthreads();
}


namespace sp {
constexpr int RS = 272;
constexpr int L_W = 0, L_V = L_W + 128 * RS, L_ST = L_V + 128 * RS, L_END = L_ST + 128 * 8;
typedef fs::rsrc_t rsrc_t;
__device__ __forceinline__ void spatial_phase(const Ctx& C) {
    LAS unsigned char* lds = C.lds; const int tid = C.tid, wave = C.wave, lane = C.lane, fr = lane & 15, fq = lane >> 4;
    const int nitems = (M / 128) * 8;
    if (C.vcu >= nitems) return;
    const int g = C.vcu & 7;
    const rsrc_t rV = fs::mk_rsrc(C.ws + WS_V2, ACT_BYTES), rU = fs::mk_rsrc(C.ws + WS_U, ACT_BYTES), rX = fs::mk_rsrc(C.ws + WS_AX, ACT_BYTES);
    const float* vs1 = C.ctlf + CW_VS1; const float* vs2 = C.ctlf + CW_VS2;
    { const h16* Wg = (const h16*)(C.ws + WS_W_WS) + (size_t)g * 128 * 128;
#pragma unroll
      for (int i = 0; i < 4; ++i) { const int idx = tid + 512 * i, row = idx >> 4, c16 = idx & 15; *(LAS u32x4*)(lds + L_W + row * RS + c16 * 16) = *(const u32x4*)(Wg + row * 128 + c16 * 8); } }
    const f32x2 lg = *(const f32x2*)(C.in[16] + g * 128 + 2 * lane), lbn = *(const f32x2*)(C.in[17] + g * 128 + 2 * lane);
    const unsigned voV = (unsigned)(g * 128 + 2 * lane) * 2u, voX = (unsigned)(fr * D + g * 128 + 16 * wave + 4 * fq) * 2u;
    for (int item = C.vcu; item < nitems; item += C.G) {
        const int r0 = (item >> 3) * 128;
        unsigned raw[16];
#pragma unroll
        for (int j = 0; j < 16; ++j) raw[j] = __builtin_amdgcn_raw_buffer_load_b32(rV, voV, (unsigned)((r0 + 16 * wave + j) * D) * 2u, 0);
        if (tid < 128) { const float mu = vs1[r0 + tid] * (1.0f / D), var = vs2[r0 + tid] * (1.0f / D) - mu * mu; *(LAS f32x2*)(lds + L_ST + tid * 8) = (f32x2){mu, rsqrtf(var + EPS)}; }
        asm volatile("s_waitcnt lgkmcnt(0)" ::: "memory"); __builtin_amdgcn_s_barrier(); asm volatile("" ::: "memory");
        { float a0[16], a1[16];
#pragma unroll
          for (int j = 0; j < 16; ++j) { const f32x2 st = *(const LAS f32x2*)(lds + L_ST + (16 * wave + j) * 8); const h16x2 hv = __builtin_bit_cast(h16x2, raw[j]);
              a0[j] = ((float)hv.x - st.x) * st.y * lg.x + lbn.x; a1[j] = ((float)hv.y - st.x) * st.y * lg.y + lbn.y; }
          u32x4 w0, w1, w2, w3;
          w0.x = pk_h16(a0[0], a0[1]); w0.y = pk_h16(a0[2], a0[3]); w0.z = pk_h16(a0[4], a0[5]); w0.w = pk_h16(a0[6], a0[7]);
          w1.x = pk_h16(a0[8], a0[9]); w1.y = pk_h16(a0[10], a0[11]); w1.z = pk_h16(a0[12], a0[13]); w1.w = pk_h16(a0[14], a0[15]);
          w2.x = pk_h16(a1[0], a1[1]); w2.y = pk_h16(a1[2], a1[3]); w2.z = pk_h16(a1[4], a1[5]); w2.w = pk_h16(a1[6], a1[7]);
          w3.x = pk_h16(a1[8], a1[9]); w3.y = pk_h16(a1[10], a1[11]); w3.z = pk_h16(a1[12], a1[13]); w3.w = pk_h16(a1[14], a1[15]);
          *(LAS u32x4*)(lds + L_V + (2 * lane) * RS + wave * 32) = w0; *(LAS u32x4*)(lds + L_V + (2 * lane) * RS + wave * 32 + 16) = w1;
          *(LAS u32x4*)(lds + L_V + (2 * lane + 1) * RS + wave * 32) = w2; *(LAS u32x4*)(lds + L_V + (2 * lane + 1) * RS + wave * 32 + 16) = w3; }
        asm volatile("s_waitcnt lgkmcnt(0)" ::: "memory"); __builtin_amdgcn_s_barrier(); asm volatile("" ::: "memory");
        h16x4 uu[8]; float bsv[8];
#pragma unroll
        for (int pt = 0; pt < 8; ++pt) { uu[pt] = __builtin_bit_cast(h16x4, __builtin_amdgcn_raw_buffer_load_b64(rU, voX, (unsigned)((r0 + 16 * pt) * D) * 2u, 0)); bsv[pt] = C.in[19][g * 128 + 16 * pt + fr]; }
        f32x4 acc[8];
#pragma unroll
        for (int pt = 0; pt < 8; ++pt) acc[pt] = (f32x4){0.f, 0.f, 0.f, 0.f};
#pragma unroll
        for (int ks = 0; ks < 4; ++ks) { const h16x8 A = *(const LAS h16x8*)(lds + L_V + (16 * wave + fr) * RS + ks * 64 + fq * 16);
#pragma unroll
            for (int pt = 0; pt < 8; ++pt) { const h16x8 B = *(const LAS h16x8*)(lds + L_W + (16 * pt + fr) * RS + ks * 64 + fq * 16); acc[pt] = __builtin_amdgcn_mfma_f32_16x16x32_f16(A, B, acc[pt], 0, 0, 0); } }
#pragma unroll
        for (int pt = 0; pt < 8; ++pt) { const float b = bsv[pt];
            u32x2 w; w.x = pk_h16((float)uu[pt].x * (acc[pt].x + b), (float)uu[pt].y * (acc[pt].y + b)); w.y = pk_h16((float)uu[pt].z * (acc[pt].z + b), (float)uu[pt].w * (acc[pt].w + b));
            __builtin_amdgcn_raw_buffer_store_b64(w, rX, voX, (unsigned)((r0 + 16 * pt) * D) * 2u, 0); }
        asm volatile("s_waitcnt lgkmcnt(0)" ::: "memory"); __builtin_amdgcn_s_barrier(); asm volatile("" ::: "memory");
    }
}
}

__device__ __forceinline__ void final_norm_phase(const Ctx& C) {
    const int gw = C.vcu * NWAVES + C.wave, NGW = C.G * NWAVES, lane = C.lane;
    const float* rsq = C.ctlf + CW_RSQ_D; const float* g = C.in[21];
    for (int row = gw; row < M; row += NGW) {
        const float rstd = rsqrtf(rsq[row] * (1.0f / D) + EPS); float* xr = C.out + (size_t)row * D;
#pragma unroll
        for (int j = 0; j < 4; ++j) { const int col = j * 256 + lane * 4; const f32x4 v = *(const f32x4*)(xr + col), gg = *(const f32x4*)(g + col); *(f32x4*)(xr + col) = v * rstd * gg; }
    }
}


#define XB_TMO      128
#define XB_XCNT(j)  (256  + 64 * (j))
#define XB_XSUB(j)  (1280 + 64 * (j))
#define XB_XGEN(j)  (2304 + 64 * (j))
#define XB_TOP      3328
#define XB_TOPGEN   3392
#define XCD_BAR_WORDS 3456
#define XB_SPIN_CAP (1u << 20)
__device__ __forceinline__ unsigned xb_ld(unsigned* p)              { return __hip_atomic_load(p, __ATOMIC_RELAXED, __HIP_MEMORY_SCOPE_AGENT); }
__device__ __forceinline__ unsigned xb_add(unsigned* p, unsigned v) { return __hip_atomic_fetch_add(p, v, __ATOMIC_RELAXED, __HIP_MEMORY_SCOPE_AGENT); }
__device__ __forceinline__ unsigned xb_xcc_id() { return (unsigned)__builtin_amdgcn_s_getreg((3 << 11) | 20) & 0xFu; }
#define XB_SPIN(cond, bar) do { unsigned _sp = 0; while (cond) { __builtin_amdgcn_s_sleep(1); \
    if ((++_sp & 255u) == 0u) { if (xb_ld(&(bar)[XB_TMO])) break; if (_sp > XB_SPIN_CAP) { atomicAdd(&(bar)[XB_TMO], 1u); break; } } } } while (0)
struct XcdBarrier { unsigned* bar; unsigned x; volatile LAS unsigned* st; };
__device__ __forceinline__ XcdBarrier xcd_barrier_post(unsigned* bar, volatile LAS unsigned* st) {
    XcdBarrier b; b.bar = bar; b.x = xb_xcc_id(); b.st = st;
    if (threadIdx.x == 0) (void)xb_add(&bar[XB_XCNT(b.x)], 1u);
    return b;
}
__device__ __forceinline__ void xcd_barrier_complete(unsigned* bar, unsigned x, unsigned& nloc, unsigned& nx) {
    const unsigned G = gridDim.x * gridDim.y * gridDim.z;
    unsigned sum, cnt, mine, sp = 0u;
    for (;;) {
        sum = 0u; cnt = 0u; mine = 0u;
#pragma unroll
        for (unsigned j = 0; j < 16; ++j) { const unsigned c = xb_ld(&bar[XB_XCNT(j)]); sum += c; cnt += (c > 0u) ? 1u : 0u; mine = (j == x) ? c : mine; }
        if (sum == G) break;
        __builtin_amdgcn_s_sleep(1);
        if ((++sp & 255u) == 0u) { if (xb_ld(&bar[XB_TMO])) break; if (sp > XB_SPIN_CAP) { atomicAdd(&bar[XB_TMO], 1u); break; } }
    }
    nloc = mine > 0u ? mine : 1u; nx = cnt > 0u ? cnt : 1u;
}
__device__ __forceinline__ void xcd_barrier(const XcdBarrier& b) {
    asm volatile("s_waitcnt vmcnt(0)" ::: "memory");
    __syncthreads();
    if (threadIdx.x == 0) {
        unsigned* bar = b.bar;
        __builtin_amdgcn_s_waitcnt(0);
        unsigned nloc = b.st[0], nx = b.st[1];
        if (nloc == 0u) { xcd_barrier_complete(bar, b.x, nloc, nx); b.st[0] = nloc; b.st[1] = nx; }
        const unsigned old = xb_add(&bar[XB_XSUB(b.x)], 1u);
        const unsigned gen = old / nloc;
        if (old + 1u == (gen + 1u) * nloc) {
            __builtin_amdgcn_fence(__ATOMIC_RELEASE, "agent");
            asm volatile("s_waitcnt vmcnt(0)" ::: "memory");
            const unsigned og = xb_add(&bar[XB_TOP], 1u);
            const unsigned tg = og / nx;
            if (og + 1u == (tg + 1u) * nx) xb_add(&bar[XB_TOPGEN], 1u);
            else XB_SPIN(xb_ld(&bar[XB_TOPGEN]) == tg, bar);
            __builtin_amdgcn_fence(__ATOMIC_ACQUIRE, "agent");
            xb_add(&bar[XB_XGEN(b.x)], 1u);
            asm volatile("s_waitcnt vmcnt(0)" ::: "memory");
        } else {
            XB_SPIN(xb_ld(&bar[XB_XGEN(b.x)]) == gen, bar);
            __builtin_amdgcn_fence(__ATOMIC_ACQUIRE, "agent");
            asm volatile("s_waitcnt vmcnt(0)" ::: "memory");
        }
    }
    __syncthreads();
}

__global__ void __launch_bounds__(NTHREADS, 2) fwd_kernel(Args args) {
    extern __shared__ __attribute__((aligned(16))) unsigned char lds_raw[];
    Ctx C;
    C.lds = (LAS unsigned char*)lds_raw;
    C.tid = threadIdx.x; C.lane = C.tid & 63; C.wave = __builtin_amdgcn_readfirstlane(C.tid >> 6);
    C.G = gridDim.x; { const int bx = blockIdx.x; C.vcu = (C.G % 8 == 0) ? (bx % 8) * (C.G / 8) + bx / 8 : bx; }
    C.in = args.in; C.out = args.out; C.ws = args.ws;
    C.ctlf = (float*)(args.ws + WS_CTL); C.vec = (float*)(args.ws + WS_VEC);
    unsigned char* ws = args.ws;
    const int lo = args.ph_lo, hi = args.ph_hi;
    float* mod = C.ctlf + CW_MOD;
    h16* AX = (h16*)(ws + WS_AX); h16* AY = (h16*)(ws + WS_AY); h16* HID = (h16*)(ws + WS_HID);
    volatile LAS unsigned* MISC = (volatile LAS unsigned*)(C.lds + MISC_OFF);
    if (C.tid < 32) MISC[C.tid] = 0u;
    __syncthreads();
    XcdBarrier bar = xcd_barrier_post((unsigned*)C.ctlf + CW_BAR, MISC + 8);
#if MK_FAST_GEMM
#define GEMM_PHASE(PERM, A, W, Mr, N, K, E) fast_gemm_phase<decltype(E), PERM>(C, A, W, Mr, N, K, E)
#else
#define GEMM_PHASE(PERM, A, W, Mr, N, K, E) naive_gemm_phase(C, A, W, Mr, N, K, E)
#endif
#define IN(k) (lo <= (k) && (k) < hi)
#define SEAM(k) do { if (IN(k) && IN((k) + 1)) xcd_barrier(bar); } while (0)
    if (IN(0)) { phase0(C); SEAM(0); }
    if (IN(1)) { phase1(C); SEAM(1); }
    if (IN(2)) { EpiWin E{(h16*)(ws + WS_Q), (h16*)C.out, (h16*)C.out + (size_t)M * D, (bf16_t*)(ws + WS_V), (h16*)(ws + WS_G)};
        GEMM_PHASE(true, AX, (const h16*)(ws + WS_W_HIN), M, N_HIN, D, E); SEAM(2); }
#if MK_SCAN_DBG
    if (IN(3)) { naive_scan_phase(C); SEAM(3); }
    if (IN(4)) { for (int it = C.vcu; it < 128; it += C.G) fs::passC_item<MK_SCAN_DBG>(C, it >> 3, it & 7, 0, 256, 0); xcd_barrier(bar); naive_combine_phase(C); SEAM(4); }
#elif MK_SCAN_HYBRID
    if (IN(3)) { naive_scan_phase(C); SEAM(3); }
    if (IN(4)) { naive_combine_phase(C); for (int it = C.vcu; it < 128; it += C.G) fs::passC_item<0>(C, it >> 3, it & 7, 0, 256, 0); SEAM(4); }
#elif MK_FAST_SCAN
    if (IN(3)) { fs::passA_phase(C); SEAM(3); }
    if (IN(4)) { fs::passC_phase(C); SEAM(4); }
#else
    if (IN(3)) { naive_scan_phase(C); SEAM(3); }
    if (IN(4)) { naive_combine_phase(C); SEAM(4); }
#endif
    if (IN(5)) { EpiRes E{C.in[0], C.in[1], C.out, mod + 2 * D, C.vec + VW_GN, AY, C.ctlf + CW_RSQ_A};
        GEMM_PHASE(false, AX, (const h16*)(ws + WS_W_HOUT), M, D, D, E); SEAM(5); }
    if (IN(6)) { EpiHid E{C.ctlf + CW_RSQ_A, C.vec + VW_BMLP, HID};
        GEMM_PHASE(true, AY, (const h16*)(ws + WS_W_W1), M, FF, D, E); SEAM(6); }
    if (IN(7)) { EpiRes E{nullptr, nullptr, C.out, mod + 5 * D, C.vec + VW_GN + NCOND * D, AY, C.ctlf + CW_RSQ_B};
        GEMM_PHASE(false, HID, (const h16*)(ws + WS_W_W2), M, D, FF, E); SEAM(7); }
    if (IN(8)) { EpiCin E{C.ctlf + CW_RSQ_B, C.vec + VW_BCM, (h16*)(ws + WS_U), (h16*)(ws + WS_V2), C.ctlf + CW_VS1, C.ctlf + CW_VS2};
        GEMM_PHASE(true, AY, (const h16*)(ws + WS_W_CIN), M, N_CIN, D, E); SEAM(8); }
#if MK_FAST_SPATIAL
    if (IN(9)) { sp::spatial_phase(C); __syncthreads(); SEAM(9); }
#else
    if (IN(9)) { naive_spatial_phase(C); SEAM(9); }
#endif
    if (IN(10)) { EpiRes E{nullptr, nullptr, C.out, mod + (size_t)NCOND * 6 * D + 2 * D, C.vec + VW_GN + 2 * NCOND * D, AY, C.ctlf + CW_RSQ_C};
        GEMM_PHASE(false, AX, (const h16*)(ws + WS_W_COUT), M, D, D, E); SEAM(10); }
    if (IN(11)) { EpiHid E{C.ctlf + CW_RSQ_C, C.vec + VW_BMLP + NCOND * FF, HID};
        GEMM_PHASE(true, AY, (const h16*)(ws + WS_W_W1 + 8 * MiB), M, FF, D, E); SEAM(11); }
    if (IN(12)) { EpiRes E{nullptr, nullptr, C.out, mod + (size_t)NCOND * 6 * D + 5 * D, nullptr, nullptr, C.ctlf + CW_RSQ_D};
        GEMM_PHASE(false, HID, (const h16*)(ws + WS_W_W2 + 8 * MiB), M, D, FF, E); SEAM(12); }
    if (IN(13)) { final_norm_phase(C); }
#undef IN
#undef SEAM
}


extern "C" void kernel_launch(void* const* d_in, const int* in_sizes, int n_in, void* d_out, int out_size, void* d_ws, size_t ws_size, hipStream_t stream) {
    static int grid = 0;
    if (grid == 0) {
        if (n_in != 22 || ws_size < WS_END) { fprintf(stderr, "kernel_launch: unexpected shapes (n_in %d, ws %zu)\n", n_in, ws_size); grid = -1; return; }
        int dev = 0, cus = 0;
        if (hipGetDevice(&dev) != hipSuccess || hipDeviceGetAttribute(&cus, hipDeviceAttributeMultiprocessorCount, dev) != hipSuccess) { grid = -1; return; }
        if (hipFuncSetAttribute((const void*)fwd_kernel, hipFuncAttributeMaxDynamicSharedMemorySize, LDS_BYTES) != hipSuccess) { fprintf(stderr, "kernel_launch: hipFuncSetAttribute failed\n"); grid = -1; return; }
        grid = cus;
    }
    if (grid < 0) return;
    (void)hipMemsetAsync((char*)d_ws + WS_CTL, 0, CTL_ZERO_BYTES, stream);
    Args a{};
    for (int i = 0; i < 22; ++i) a.in[i] = (const float*)d_in[i];
    a.out = (float*)d_out; a.ws = (unsigned char*)d_ws;
#if MK_LAUNCH_PER_PHASE
    for (int p = 0; p < NPHASES; ++p) { a.ph_lo = p; a.ph_hi = p + 1; hipLaunchKernelGGL(fwd_kernel, dim3(grid), dim3(NTHREADS), LDS_BYTES, stream, a); }
#else
    a.ph_lo = 0; a.ph_hi = NPHASES; hipLaunchKernelGGL(fwd_kernel, dim3(grid), dim3(NTHREADS), LDS_BYTES, stream, a);
#endif
}
```
